# Optimizing an MI355X kernel written in HIP

```python
import math
import jax, jax.numpy as jnp
from jax import lax
import numpy as np

D_MODEL = 1024
BATCH = 2
SEQ = 16384
DEPTH = 2
DEC_BATCH = 8
DEC_SEQ = 4096
PAST_LEN = 128

N_MIXERS = 2
N_FOURIER_LAYERS = (DEPTH + 1) // 2
N_MLA_LAYERS = DEPTH // 2
N_FOURIER_GROUPS = 4
FOURIER_GROUP_DIM = D_MODEL // N_FOURIER_GROUPS
N_HEADS = 8
QK_NOPE_DIM = 128
QK_ROPE_DIM = 64
V_HEAD_DIM = 128
Q_LORA_RANK = 256
KV_LORA_RANK = 256
ROPE_THETA = 10000.0
Q_BLOCK = 128
D_FF = ((8 * D_MODEL // 3 + 255) // 256) * 256
NORM_EPS = 1e-6

kernel_name = "fnet_mla_interleaved_encoder"


def rms_norm(x, g):
    xf = x.astype(jnp.float32)
    y = xf * lax.rsqrt(jnp.mean(xf * xf, axis=-1, keepdims=True) + NORM_EPS)
    return (y * g.astype(jnp.float32)).astype(x.dtype)


def rope_tables(seq_len, dtype):
    inv_freq = 1.0 / (ROPE_THETA ** (jnp.arange(0, QK_ROPE_DIM, 2, dtype=jnp.float32) / QK_ROPE_DIM))
    ang = jnp.arange(seq_len, dtype=jnp.float32)[:, None] * inv_freq[None, :]
    return jnp.cos(ang).astype(dtype), jnp.sin(ang).astype(dtype)


def apply_rope(x, cos, sin):
    half = x.shape[-1] // 2
    x1, x2 = x[..., :half], x[..., half:]
    return jnp.concatenate([x1 * cos - x2 * sin, x2 * cos + x1 * sin], axis=-1)


def mixer_fourier(h, w_out, b_out):
    B, S, D = h.shape
    hg = h.astype(jnp.float32).reshape(B, S, N_FOURIER_GROUPS, FOURIER_GROUP_DIM)
    mixed = jnp.real(jnp.fft.fft2(hg, axes=(1, 3))).reshape(B, S, D).astype(h.dtype)
    return mixed @ w_out + b_out


def blocked_attention(q_nope, q_rope, k_nope, k_rope, v):
    B, S, H, Dn = q_nope.shape
    nb = S // Q_BLOCK
    scale = 1.0 / math.sqrt(QK_NOPE_DIM + QK_ROPE_DIM)
    qn = q_nope.reshape(B, nb, Q_BLOCK, H, Dn).transpose(1, 0, 2, 3, 4)
    qr = q_rope.reshape(B, nb, Q_BLOCK, H, QK_ROPE_DIM).transpose(1, 0, 2, 3, 4)

    def one_block(args):
        qn_b, qr_b = args
        s = (jnp.einsum('bqhd,bkhd->bhqk', qn_b, k_nope, preferred_element_type=jnp.float32)
             + jnp.einsum('bqhr,bkr->bhqk', qr_b, k_rope, preferred_element_type=jnp.float32)) * scale
        p = jax.nn.softmax(s, axis=-1).astype(v.dtype)
        return jnp.einsum('bhqk,bkhd->bqhd', p, v)

    out = lax.map(one_block, (qn, qr))
    return out.transpose(1, 0, 2, 3, 4).reshape(B, S, H, V_HEAD_DIM)


def mixer_mla(h, w_down, q_norm, w_uq, kv_norm, w_ukv, w_o):
    B, S, _ = h.shape
    down = h @ w_down
    c_q = down[..., :Q_LORA_RANK]
    c_kv = down[..., Q_LORA_RANK:Q_LORA_RANK + KV_LORA_RANK]
    k_rope = down[..., Q_LORA_RANK + KV_LORA_RANK:]
    q = (rms_norm(c_q, q_norm) @ w_uq).reshape(B, S, N_HEADS, QK_NOPE_DIM + QK_ROPE_DIM)
    q_nope, q_rope = q[..., :QK_NOPE_DIM], q[..., QK_NOPE_DIM:]
    kv = (rms_norm(c_kv, kv_norm) @ w_ukv).reshape(B, S, N_HEADS, QK_NOPE_DIM + V_HEAD_DIM)
    k_nope, v = kv[..., :QK_NOPE_DIM], kv[..., QK_NOPE_DIM:]
    cos, sin = rope_tables(S, h.dtype)
    q_rope = apply_rope(q_rope, cos[:, None, :], sin[:, None, :])
    k_rope = apply_rope(k_rope, cos, sin)
    o = blocked_attention(q_nope, q_rope, k_nope, k_rope, v)
    return o.reshape(B, S, N_HEADS * V_HEAD_DIM) @ w_o


def swiglu_ffn(h, w_gate, w_up, w_down):
    return (jax.nn.silu(h @ w_gate) * (h @ w_up)) @ w_down


def trunk(x, norm_g, fnet_w_out, fnet_b_out, mla_w_down, mla_q_norm, mla_w_uq,
          mla_kv_norm, mla_w_ukv, mla_w_o, ffn_w_gate, ffn_w_up, ffn_w_down):
    for i in range(DEPTH):
        g = norm_g[i]
        j = i // N_MIXERS
        hn = rms_norm(x, g[0])
        if i % N_MIXERS == 0:
            m = mixer_fourier(hn, fnet_w_out[j], fnet_b_out[j])
        else:
            m = mixer_mla(hn, mla_w_down[j], mla_q_norm[j], mla_w_uq[j],
                          mla_kv_norm[j], mla_w_ukv[j], mla_w_o[j])
        x = x + rms_norm(m, g[1])
        f = swiglu_ffn(rms_norm(x, g[2]), ffn_w_gate[i], ffn_w_up[i], ffn_w_down[i])
        x = x + rms_norm(f, g[3])
    return x


def setup_inputs(seed: int = 0) -> dict:
    key = jax.random.key(seed)
    ks = jax.random.split(key, 16)

    def w(k, shape, fan_in):
        return jax.random.normal(k, shape, jnp.float32) * (fan_in ** -0.5)

    def gain(k, shape):
        return 1.0 + 0.02 * jax.random.normal(k, shape, jnp.float32)

    return {
        "x_prompt": jax.random.normal(ks[0], (BATCH, SEQ, D_MODEL), jnp.float32),
        "x_sample": jax.random.normal(ks[1], (DEC_BATCH, DEC_SEQ, D_MODEL), jnp.float32),
        "norm_g": gain(ks[2], (DEPTH, 4, D_MODEL)),
        "fnet_w_out": w(ks[3], (N_FOURIER_LAYERS, D_MODEL, D_MODEL), D_MODEL),
        "fnet_b_out": 0.02 * jax.random.normal(ks[4], (N_FOURIER_LAYERS, D_MODEL), jnp.float32),
        "mla_w_down": w(ks[5], (N_MLA_LAYERS, D_MODEL, Q_LORA_RANK + KV_LORA_RANK + QK_ROPE_DIM), D_MODEL),
        "mla_q_norm": gain(ks[6], (N_MLA_LAYERS, Q_LORA_RANK)),
        "mla_w_uq": w(ks[7], (N_MLA_LAYERS, Q_LORA_RANK, N_HEADS * (QK_NOPE_DIM + QK_ROPE_DIM)), Q_LORA_RANK),
        "mla_kv_norm": gain(ks[8], (N_MLA_LAYERS, KV_LORA_RANK)),
        "mla_w_ukv": w(ks[9], (N_MLA_LAYERS, KV_LORA_RANK, N_HEADS * (QK_NOPE_DIM + V_HEAD_DIM)), KV_LORA_RANK),
        "mla_w_o": w(ks[10], (N_MLA_LAYERS, N_HEADS * V_HEAD_DIM, D_MODEL), N_HEADS * V_HEAD_DIM),
        "ffn_w_gate": w(ks[11], (DEPTH, D_MODEL, D_FF), D_MODEL),
        "ffn_w_up": w(ks[12], (DEPTH, D_MODEL, D_FF), D_MODEL),
        "ffn_w_down": w(ks[13], (DEPTH, D_FF, D_MODEL), D_FF),
    }


def reference(x_prompt, x_sample, norm_g, fnet_w_out, fnet_b_out, mla_w_down, mla_q_norm,
              mla_w_uq, mla_kv_norm, mla_w_ukv, mla_w_o, ffn_w_gate, ffn_w_up, ffn_w_down):
    y_prompt = trunk(x_prompt, norm_g, fnet_w_out, fnet_b_out, mla_w_down, mla_q_norm, mla_w_uq,
                     mla_kv_norm, mla_w_ukv, mla_w_o, ffn_w_gate, ffn_w_up, ffn_w_down)
    y_sample = trunk(x_sample, norm_g, fnet_w_out, fnet_b_out, mla_w_down, mla_q_norm, mla_w_uq,
                     mla_kv_norm, mla_w_ukv, mla_w_o, ffn_w_gate, ffn_w_up, ffn_w_down)
    return (y_prompt, y_sample)
```

```cpp
#include <hip/hip_runtime.h>
#include <hip/hip_cooperative_groups.h>
#include <cstdint>
#include <cstdio>
namespace cg = cooperative_groups;

#define DI __device__ __forceinline__
#define LAS __attribute__((address_space(3)))
typedef unsigned short bf16_t;
typedef short bf16x8 __attribute__((ext_vector_type(8)));
typedef short s16x4 __attribute__((ext_vector_type(4)));
typedef float f32x4 __attribute__((ext_vector_type(4)));
typedef float f32x16 __attribute__((ext_vector_type(16)));
typedef unsigned u32x4 __attribute__((ext_vector_type(4)));
typedef unsigned u32x2 __attribute__((ext_vector_type(2)));

constexpr int T_ALL = 65536, T_HALF = 32768, DM = 1024, DFF = 2816;
constexpr int S_P = 16384, S_S = 4096;
constexpr float NORM_EPS = 1e-6f;
constexpr float QSCALE = 0.07216878364870322f * 1.4426950408889634f;

constexpr size_t MiB = 1u << 20;
constexpr size_t WS_ROPE = 1 * MiB;
constexpr size_t WS_WFN  = 5 * MiB;
constexpr size_t WS_DFT  = 7 * MiB;
constexpr size_t WS_WDN  = 7 * MiB + 512 * 1024;
constexpr size_t WS_WUQ  = 9 * MiB;
constexpr size_t WS_WUKV = 10 * MiB;
constexpr size_t WS_WO   = 11 * MiB;
constexpr size_t WS_WGU  = 14 * MiB;
constexpr size_t WS_WFD  = 25 * MiB;
constexpr size_t WS_RSTD = 31 * MiB;
constexpr size_t WS_H    = 32 * MiB;
constexpr size_t WS_G    = 160 * MiB;
constexpr size_t WS_TP   = WS_G;
constexpr size_t WS_PQ   = WS_G + 128 * MiB;
constexpr size_t WS_M    = WS_G;
constexpr size_t WS_ACT  = WS_G;
constexpr size_t WS_F    = WS_G + 176 * MiB;
constexpr size_t WS_DOWN = WS_G;
constexpr size_t WS_CQ   = WS_G + 96 * MiB;
constexpr size_t WS_CKV  = WS_G + 128 * MiB;
constexpr size_t WS_KR   = WS_G + 160 * MiB;
constexpr size_t WS_Q    = 32 * MiB;
constexpr size_t WS_KN   = WS_G + 176 * MiB;
constexpr size_t WS_V    = WS_G + 240 * MiB;
constexpr size_t WS_M2   = WS_G + 176 * MiB;
constexpr size_t WS_END  = 464 * MiB;

DI int otid(int wv) { int l; asm volatile("v_mbcnt_lo_u32_b32 %0, -1, 0\n\tv_mbcnt_hi_u32_b32 %0, -1, %0" : "=v"(l)); return wv * 64 + l; }
typedef float f32x2_t __attribute__((ext_vector_type(2)));
typedef __bf16 bf16x2_t __attribute__((ext_vector_type(2)));
DI unsigned cvt_pk_bf16(float lo, float hi) { const f32x2_t v = {lo, hi}; const bf16x2_t b = __builtin_convertvector(v, bf16x2_t); return __builtin_bit_cast(unsigned, b); }
DI bf16_t f2bf(float x) { return (bf16_t)(cvt_pk_bf16(x, x) & 0xffffu); }
DI float bf2f(unsigned b) { return __uint_as_float(b << 16); }
DI float wave_sum(float v) {
#pragma unroll
    for (int o = 1; o < 64; o <<= 1) v += __shfl_xor(v, o);
    return v;
}
#define GAS __attribute__((address_space(1)))
DI bf16x8 gld_bf8(const void* p) { return *(const GAS bf16x8*)p; }
DI u32x4 gld_u4(const void* p) { return *(const GAS u32x4*)p; }
DI f32x4 gld_f4(const void* p) { return *(const GAS f32x4*)p; }
DI void gst_u4(void* p, u32x4 v) { *(GAS u32x4*)p = v; }
DI void gst_u2(void* p, u32x2 v) { *(GAS u32x2*)p = v; }
DI void gst_f4(void* p, f32x4 v) { *(GAS f32x4*)p = v; }
DI void gst_h(void* p, bf16_t v) { *(GAS bf16_t*)p = v; }
DI float cos2pi(float frac) { return __builtin_amdgcn_cosf(frac); }
DI float sin2pi(float frac) { return __builtin_amdgcn_sinf(frac); }

namespace pg8 {
constexpr int BM = 256, BK = 64, HALF = 128, HTB = HALF * BK * 2, STAGE_BYTES = 8 * HTB, NXCD = 8, WGM = 8;
DI int lds_byte(int r, int c) { const int st = (r >> 4) * 2 + (c >> 5), rr = r & 15, cc = c & 31, ob = rr * 64 + cc * 2; return st * 1024 + (ob ^ (((ob >> 9) & 1) << 5)); }
DI void stage_rc(int b, int& R, int& C) { const int st = b / 1024, sb = b % 1024, swz = sb ^ (((sb >> 9) & 1) << 5); R = (st >> 1) * 16 + swz / 64; C = (st & 1) * 32 + (swz % 64) / 2; }
DI int perm32(int rho) { const int n = rho >> 4, i = rho & 15; return 8 * (i >> 2) + 4 * n + (i & 3); }

struct Unit { int pm, pn; };
struct Gemm { const bf16_t* A; const bf16_t* Bt; int M, N, K, lda; long a_pn_off; int b_shared; int askip; };

struct StaticOrder {
    int nM, nN, nwg, G, c;
    DI void init(int M, int N, int G_, int c_) { nM = M / BM; nN = N / BM; nwg = nM * nN; G = G_; c = c_; }
    DI bool next(int i, Unit& u) const {
        const long L = (long)i * G + c; if (L >= nwg) return false;
        int wgid = (int)L; { const int q = nwg / NXCD, r = nwg % NXCD, xcd = wgid % NXCD, off = wgid / NXCD; wgid = (xcd < r ? xcd * (q + 1) : r * (q + 1) + (xcd - r) * q) + off; }
        const int nig = WGM * nN, gid = wgid / nig, fm = gid * WGM, gsz = (nM - fm) < WGM ? (nM - fm) : WGM;
        u.pm = fm + ((wgid % nig) % gsz); u.pn = (wgid % nig) / gsz; return true;
    }
};

struct EpiStore {
    bf16_t* O; int ldc; const float* bias; const float* rs;
    DI void operator()(const f32x4 (&acc)[2][2][4][2], const Unit& u, int wr, int wc, int fr, int fq) const {
        const int row0 = u.pm * BM + wr * 64 + fr; const int col0 = u.pn * BM + wc * 32 + 8 * fq;
        f32x4 bv[2][2];
#pragma unroll
        for (int bj = 0; bj < 2; ++bj)
#pragma unroll
            for (int n = 0; n < 2; ++n) bv[bj][n] = bias ? *(const f32x4*)(bias + col0 + bj * HALF + 4 * n) : (f32x4){0.f, 0.f, 0.f, 0.f};
#pragma unroll
        for (int ai = 0; ai < 2; ++ai)
#pragma unroll
            for (int m = 0; m < 4; ++m) { const int row = row0 + ai * HALF + m * 16; bf16_t* rowp = O + (size_t)row * ldc + col0;
                const float sc = rs ? rs[row] : 1.f;
#pragma unroll
                for (int bj = 0; bj < 2; ++bj) { f32x4 v0 = (acc[ai][bj][m][0] + bv[bj][0]) * sc, v1 = (acc[ai][bj][m][1] + bv[bj][1]) * sc;
                    u32x4 w; w.x = cvt_pk_bf16(v0[0], v0[1]); w.y = cvt_pk_bf16(v0[2], v0[3]); w.z = cvt_pk_bf16(v1[0], v1[1]); w.w = cvt_pk_bf16(v1[2], v1[3]);
                    *(u32x4*)(rowp + bj * HALF) = w; } }
    }
};
DI float silu_mul(float g, float u) { return g * __builtin_amdgcn_rcpf(1.f + __builtin_amdgcn_exp2f(-1.4426950408889634f * g)) * u; }
struct EpiSwiGLU {
    bf16_t* O; const float* rs;
    DI void operator()(const f32x4 (&acc)[2][2][4][2], const Unit& u, int wr, int wc, int fr, int fq) const {
        const int row0 = u.pm * BM + wr * 64 + fr; const int col0 = u.pn * HALF + wc * 32 + 8 * fq;
#pragma unroll
        for (int ai = 0; ai < 2; ++ai)
#pragma unroll
            for (int m = 0; m < 4; ++m) { const int row = row0 + ai * HALF + m * 16; bf16_t* rowp = O + (size_t)row * DFF + col0; const float sc = rs[row];
                const f32x4 g0 = acc[ai][0][m][0] * sc, g1 = acc[ai][0][m][1] * sc, u0 = acc[ai][1][m][0] * sc, u1 = acc[ai][1][m][1] * sc;
                u32x4 w; w.x = cvt_pk_bf16(silu_mul(g0[0], u0[0]), silu_mul(g0[1], u0[1])); w.y = cvt_pk_bf16(silu_mul(g0[2], u0[2]), silu_mul(g0[3], u0[3]));
                w.z = cvt_pk_bf16(silu_mul(g1[0], u1[0]), silu_mul(g1[1], u1[1])); w.w = cvt_pk_bf16(silu_mul(g1[2], u1[2]), silu_mul(g1[3], u1[3]));
                *(u32x4*)rowp = w; }
    }
};
struct EpiQ {
    bf16_t* O; const float* rope;
    DI void operator()(const f32x4 (&acc)[2][2][4][2], const Unit& u, int wr, int wc, int fr, int fq) const {
        const int row0 = u.pm * BM + wr * 64 + fr;
#pragma unroll
        for (int ai = 0; ai < 2; ++ai)
#pragma unroll
            for (int m = 0; m < 4; ++m) { const int row = row0 + ai * HALF + m * 16; const int pos = row < T_HALF ? (row & (S_P - 1)) : (row & (S_S - 1));
#pragma unroll
                for (int bj = 0; bj < 2; ++bj) { const int cb32 = u.pn * BM + bj * HALF + wc * 32, c0 = cb32 + 8 * fq; const int hcb = cb32 % 192;
                    f32x4 v0 = acc[ai][bj][m][0], v1 = acc[ai][bj][m][1];
                    if (hcb >= 128) { const int t = ((hcb - 128) >> 3) + fq; const float* cs = rope + ((size_t)pos * 32 + 4 * t) * 2;
                        const f32x4 a = *(const f32x4*)cs, b = *(const f32x4*)(cs + 4);
                        const f32x4 cv = {a[0], a[2], b[0], b[2]}, sv = {a[1], a[3], b[1], b[3]};
                        const f32x4 o1 = v0 * cv - v1 * sv, o2 = v1 * cv + v0 * sv; v0 = o1; v1 = o2; }
                    u32x4 w; w.x = cvt_pk_bf16(v0[0], v0[1]); w.y = cvt_pk_bf16(v0[2], v0[3]); w.z = cvt_pk_bf16(v1[0], v1[1]); w.w = cvt_pk_bf16(v1[2], v1[3]);
                    *(u32x4*)(O + (size_t)row * 1536 + c0) = w; }
                __builtin_amdgcn_sched_barrier(0); }
    }
};
struct EpiKV {
    bf16_t* Kn; bf16_t* V;
    DI void operator()(const f32x4 (&acc)[2][2][4][2], const Unit& u, int wr, int wc, int fr, int fq) const {
        const int row0 = u.pm * BM + wr * 64 + fr; const int col0 = u.pn * HALF + wc * 32 + 8 * fq;
#pragma unroll
        for (int ai = 0; ai < 2; ++ai)
#pragma unroll
            for (int m = 0; m < 4; ++m) { const size_t off = (size_t)(row0 + ai * HALF + m * 16) * 1024 + col0;
#pragma unroll
                for (int bj = 0; bj < 2; ++bj) { const f32x4 v0 = acc[ai][bj][m][0], v1 = acc[ai][bj][m][1];
                    u32x4 w; w.x = cvt_pk_bf16(v0[0], v0[1]); w.y = cvt_pk_bf16(v0[2], v0[3]); w.z = cvt_pk_bf16(v1[0], v1[1]); w.w = cvt_pk_bf16(v1[2], v1[3]);
                    *(u32x4*)((bj ? V : Kn) + off) = w; } }
    }
};

template <class Epi>
DI void gemm_phase(LAS unsigned char* lds, const Gemm g, const StaticOrder& S, const Epi& E, int wv) {
    const int tid = otid(wv), wid = __builtin_amdgcn_readfirstlane(tid >> 6), lane = tid & 63, wr = wid >> 2, wc = wid & 3, fr = lane & 15, fq = lane >> 4;
    int K = g.K; asm volatile("" : "+s"(K));
    const int nt = K / BK;
    unsigned voffA[2], voffB[2];
#pragma unroll
    for (int i = 0; i < 2; ++i) { int R, C; stage_rc(tid * 16 + i * 8192, R, C); const int Rb = (R & ~31) + perm32(R & 31);
        voffA[i] = (unsigned)(R * g.lda + C) * 2u; voffB[i] = (unsigned)(Rb * K + C) * 2u; }
    const size_t kstep = (size_t)(BK * 2);
    const size_t hA = (size_t)HALF * g.lda * 2, tA = 2 * hA;
    const size_t hB = (size_t)HALF * K * 2, tB = g.b_shared ? 0 : 2 * hB;
    const unsigned ldsw = (unsigned)wid * 1024u;
    const int aoff = lds_byte(wr * 64 + fr, fq * 8), boff = lds_byte(wc * 32 + fr, fq * 8);
#define PG8_SA(b, h) (((b) * 2 + (h)) * HTB)
#define PG8_SB(b, h) ((4 + (b) * 2 + (h)) * HTB)
#define PG8_STAGE(bufoff, gbase, voff) do { _Pragma("unroll") for (int _i = 0; _i < 2; ++_i) \
        __builtin_amdgcn_global_load_lds((const unsigned*)((const char*)(gbase) + (voff)[_i]), (LAS unsigned*)(lds + (bufoff) + ldsw + _i * 8192), 16, 0, 0); } while (0)
#define PG8_LDA(dst, b, h) do { _Pragma("unroll") for (int m = 0; m < 4; ++m) _Pragma("unroll") for (int k = 0; k < 2; ++k) dst[m][k] = *(const LAS bf16x8*)(lds + PG8_SA(b, h) + aoff + m * 2048 + k * 1024); } while (0)
#define PG8_LDB(dst, b, h) do { _Pragma("unroll") for (int n = 0; n < 2; ++n) _Pragma("unroll") for (int k = 0; k < 2; ++k) dst[n][k] = *(const LAS bf16x8*)(lds + PG8_SB(b, h) + boff + n * 2048 + k * 1024); } while (0)
#define PG8_MMA(ai, bj, At, Bt) do { __builtin_amdgcn_s_setprio(1); _Pragma("unroll") for (int m = 0; m < 4; ++m) _Pragma("unroll") for (int n = 0; n < 2; ++n) _Pragma("unroll") for (int k = 0; k < 2; ++k) \
        acc[ai][bj][m][n] = __builtin_amdgcn_mfma_f32_16x16x32_bf16(Bt[n][k], At[m][k], acc[ai][bj][m][n], 0, 0, 0); __builtin_amdgcn_s_setprio(0); } while (0)
#define PG8_WAIT_V(n) asm volatile("s_waitcnt vmcnt(" #n ")" ::: "memory")
#define PG8_WAIT_L(n) asm volatile("s_waitcnt lgkmcnt(" #n ")" ::: "memory")
#define PG8_BAR __builtin_amdgcn_s_barrier()
#define PG8_SCHED __builtin_amdgcn_sched_barrier(0)
    Unit cur, nxt; int ui = 0;
    if (!S.next(0, cur)) return;
    f32x4 acc[2][2][4][2];
#pragma unroll
    for (int a = 0; a < 2; ++a)
#pragma unroll
        for (int b = 0; b < 2; ++b)
#pragma unroll
            for (int m = 0; m < 4; ++m)
#pragma unroll
                for (int n = 0; n < 2; ++n) acc[a][b][m][n] = (f32x4){0.f, 0.f, 0.f, 0.f};
    bf16x8 At[4][2], B0[2][2], B1[2][2];
    const char* cA = (const char*)g.A + (size_t)cur.pm * tA + (size_t)cur.pn * g.a_pn_off; const char* cB = (const char*)g.Bt + (size_t)cur.pn * tB;
    PG8_STAGE(PG8_SB(0, 0), cB, voffB); PG8_STAGE(PG8_SB(0, 1), cB + hB, voffB); PG8_STAGE(PG8_SA(0, 0), cA, voffA); PG8_STAGE(PG8_SA(0, 1), cA + hA, voffA);
    if (wr == 1) PG8_BAR;
    PG8_WAIT_V(2); PG8_BAR;
    PG8_STAGE(PG8_SB(1, 0), cB + kstep, voffB); PG8_STAGE(PG8_SA(1, 0), cA + kstep, voffA); PG8_STAGE(PG8_SB(1, 1), cB + hB + kstep, voffB);
    PG8_WAIT_V(6); PG8_BAR;
    for (;;) {
        const bool has_next = S.next(ui + 1, nxt);
        const char* nA = has_next ? (const char*)g.A + (size_t)nxt.pm * tA + (size_t)nxt.pn * g.a_pn_off : cA; const char* nB = has_next ? (const char*)g.Bt + (size_t)nxt.pn * tB : cB;
        for (int t = 0; t < nt; t += 2) {
            const bool last = (t == nt - 2);
            const size_t sk1 = g.askip ? (size_t)((t + 1) >> 1) * kstep : 0, sk2 = g.askip ? (size_t)((t + 2) >> 1) * kstep : 0, sk3 = g.askip ? (size_t)((t + 3) >> 1) * kstep : 0;
            const char* a1 = cA + (size_t)(t + 1) * kstep + sk1;
            const char* a2 = last ? nA : cA + (size_t)(t + 2) * kstep + sk2; const char* b2 = last ? nB : cB + (size_t)(t + 2) * kstep;
            const char* a3 = last ? nA + kstep : cA + (size_t)(t + 3) * kstep + sk3; const char* b3 = b2 + kstep;
            PG8_LDB(B0, 0, 0); PG8_LDB(B1, 0, 1); PG8_SCHED; PG8_LDA(At, 0, 0); PG8_STAGE(PG8_SA(1, 1), a1 + hA, voffA);
            PG8_WAIT_V(8); PG8_WAIT_L(0); PG8_BAR; PG8_MMA(0, 0, At, B0); PG8_MMA(0, 1, At, B1); PG8_BAR; PG8_SCHED;
            PG8_LDA(At, 0, 1); PG8_STAGE(PG8_SB(0, 0), b2, voffB); PG8_STAGE(PG8_SB(0, 1), b2 + hB, voffB); PG8_STAGE(PG8_SA(0, 0), a2, voffA);
            PG8_WAIT_V(8); PG8_WAIT_L(0); PG8_BAR; PG8_MMA(1, 0, At, B0); PG8_MMA(1, 1, At, B1); PG8_BAR; PG8_SCHED;
            PG8_LDB(B0, 1, 0); PG8_LDB(B1, 1, 1); PG8_SCHED; PG8_LDA(At, 1, 0); PG8_STAGE(PG8_SA(0, 1), a2 + hA, voffA);
            PG8_WAIT_V(8); PG8_WAIT_L(0); PG8_BAR; PG8_MMA(0, 0, At, B0); PG8_MMA(0, 1, At, B1); PG8_BAR; PG8_SCHED;
            PG8_LDA(At, 1, 1); PG8_STAGE(PG8_SB(1, 0), b3, voffB); PG8_STAGE(PG8_SB(1, 1), b3 + hB, voffB); PG8_STAGE(PG8_SA(1, 0), a3, voffA);
            PG8_WAIT_V(8); PG8_WAIT_L(0); PG8_BAR; PG8_MMA(1, 0, At, B0); PG8_MMA(1, 1, At, B1); PG8_BAR; PG8_SCHED;
        }
        if (wr == 0) PG8_BAR;
        { const int l2 = otid(wv) & 63; E(acc, cur, wr, wc, l2 & 15, l2 >> 4); }
        if (!has_next) break;
#pragma unroll
        for (int a = 0; a < 2; ++a)
#pragma unroll
            for (int b = 0; b < 2; ++b)
#pragma unroll
                for (int m = 0; m < 4; ++m)
#pragma unroll
                    for (int n = 0; n < 2; ++n) acc[a][b][m][n] = (f32x4){0.f, 0.f, 0.f, 0.f};
        cur = nxt; cA = nA; cB = nB; ++ui;
        if (wr == 1) PG8_BAR;
    }
    PG8_WAIT_V(0);
    PG8_BAR;
#undef PG8_SA
#undef PG8_SB
#undef PG8_STAGE
#undef PG8_LDA
#undef PG8_LDB
#undef PG8_MMA
#undef PG8_WAIT_V
#undef PG8_WAIT_L
#undef PG8_BAR
#undef PG8_SCHED
}
}

namespace att {
constexpr int NW = 8, QBLK = 32, KVBLK = 64;
constexpr int SHM_V = KVBLK * 128 * 2, SHM_K = KVBLK * 192 * 2;
constexpr int NVS = 3;
constexpr int QR_OFF = NVS * SHM_V + 2 * SHM_K + NW * 64 * 4;
constexpr int LDS_BYTES = QR_OFF + NW * 4096;
constexpr float THR2 = 11.5415603f;
#define KSWZ(row, colB) ((row) * 384 + ((colB) ^ ((((row) >> 1) & 7) << 4)))
#define SBAR() __builtin_amdgcn_sched_barrier(0)
#define LDS_BARRIER() do { SBAR(); asm volatile("s_waitcnt lgkmcnt(0)" ::: "memory"); __builtin_amdgcn_s_barrier(); SBAR(); } while (0)
DI int crow(int r, int hi) { return (r & 3) + 8 * (r >> 2) + 4 * hi; }

DI void partialSM(f32x16& p0, f32x16& p1, float& m_reg, f32x16& negm, float& alpha, bool first) {
    float pmax = p0[0];
#pragma unroll
    for (int r = 1; r < 16; ++r) pmax = fmaxf(pmax, p0[r]);
#pragma unroll
    for (int r = 0; r < 16; ++r) pmax = fmaxf(pmax, p1[r]);
    { auto rr = __builtin_amdgcn_permlane32_swap(__float_as_uint(pmax), __float_as_uint(pmax), false, false);
      pmax = fmaxf(__uint_as_float(rr[0]), __uint_as_float(rr[1])); }
    if (__builtin_expect(!first && __all(pmax <= THR2), 1)) { alpha = 1.f; }
    else { const float delta = first ? pmax : fmaxf(pmax, 0.f); alpha = first ? 0.f : __builtin_amdgcn_exp2f(-delta); m_reg += delta;
#pragma unroll
        for (int r = 0; r < 16; ++r) { p0[r] = p0[r] - delta; p1[r] = p1[r] - delta; negm[r] = -m_reg; } }
#pragma unroll
    for (int r = 0; r < 16; ++r) p0[r] = __builtin_amdgcn_exp2f(p0[r]);
}
DI void finishSM(f32x16& p0, f32x16& p1, float alpha, float& l_reg, bf16x8& pa0, bf16x8& pa1, bf16x8& pa2, bf16x8& pa3) {
#pragma unroll
    for (int r = 0; r < 16; ++r) p1[r] = __builtin_amdgcn_exp2f(p1[r]);
    float ps = 0;
#pragma unroll
    for (int r = 0; r < 16; ++r) ps += p0[r];
#pragma unroll
    for (int r = 0; r < 16; ++r) ps += p1[r];
    { auto rr = __builtin_amdgcn_permlane32_swap(__float_as_uint(ps), __float_as_uint(ps), false, false);
      ps = __uint_as_float(rr[0]) + __uint_as_float(rr[1]); }
    l_reg = l_reg * alpha + ps;
#define PK4(P, BASE, OUT) do { unsigned a0 = cvt_pk_bf16(P[BASE + 0], P[BASE + 1]), a1 = cvt_pk_bf16(P[BASE + 2], P[BASE + 3]);   \
    unsigned b0 = cvt_pk_bf16(P[BASE + 4], P[BASE + 5]), b1 = cvt_pk_bf16(P[BASE + 6], P[BASE + 7]);                              \
    auto r0 = __builtin_amdgcn_permlane32_swap(a0, b0, false, false); auto r1 = __builtin_amdgcn_permlane32_swap(a1, b1, false, false); \
    u32x4 w = {r0[0], r1[0], r0[1], r1[1]}; OUT = *reinterpret_cast<bf16x8*>(&w); } while (0)
    PK4(p0, 0, pa0); PK4(p0, 8, pa1); PK4(p1, 0, pa2); PK4(p1, 8, pa3);
#undef PK4
}
DI void qkt(f32x16& p0, f32x16& p1, const f32x16& negm, const char* Ks, const bf16x8* qr, const char* qrl, const int (&kb)[4]) {
    bf16x8 b0[3], b1[3];
#define KLD(d) do { const char* kp_ = Ks + kb[(d) & 3] + ((d) >> 2) * 128; b0[(d) % 3] = *reinterpret_cast<const bf16x8*>(kp_); b1[(d) % 3] = *reinterpret_cast<const bf16x8*>(kp_ + 32 * 384); } while (0)
    KLD(0); KLD(1);
    __builtin_amdgcn_s_setprio(1);
#pragma unroll
    for (int d0 = 0; d0 < 12; ++d0) {
        if (d0 + 2 < 12) KLD(d0 + 2);
        SBAR();
        const bf16x8 qf = d0 < 8 ? qr[d0 < 8 ? d0 : 0] : *reinterpret_cast<const bf16x8*>(qrl + (d0 - 8) * 1024);
        p0 = __builtin_amdgcn_mfma_f32_32x32x16_bf16(b0[d0 % 3], qf, d0 == 0 ? negm : p0, 0, 0, 0);
        p1 = __builtin_amdgcn_mfma_f32_32x32x16_bf16(b1[d0 % 3], qf, d0 == 0 ? negm : p1, 0, 0, 0);
        SBAR(); }
    __builtin_amdgcn_s_setprio(0);
#undef KLD
}
DI int v_st(int k, int c) { const int kk = (k & ~0xC) | ((k & 4) << 1) | ((k & 8) >> 1); return ((kk >> 3) * 4 + (c >> 5)) * 512 + ((kk & 7) * 32 + (c & 31)) * 2; }
DI int v_rd_base(int lane) { return ((lane & 3) << 3) | (((lane >> 2) & 3) << 6) | (((lane >> 4) & 1) << 5) | (((lane >> 5) & 1) << 8); }
constexpr int v_rd_off(int d0, int ks, int half) { return d0 * 512 + ks * 4096 + half * 2048; }
template <int OFF> DI s16x4 tr_read(int vb) {
    s16x4 r; asm volatile("ds_read_b64_tr_b16 %0, %1 offset:%2" : "=&v"(r) : "v"(vb), "i"(OFF) : "memory"); return r;
}
#define PV_READS(D0, L0, H0, L1, H1, L2, H2, L3, H3) do { L0 = tr_read<v_rd_off(D0, 0, 0)>(vb); H0 = tr_read<v_rd_off(D0, 0, 1)>(vb); L1 = tr_read<v_rd_off(D0, 1, 0)>(vb); H1 = tr_read<v_rd_off(D0, 1, 1)>(vb); \
    L2 = tr_read<v_rd_off(D0, 2, 0)>(vb); H2 = tr_read<v_rd_off(D0, 2, 1)>(vb); L3 = tr_read<v_rd_off(D0, 3, 0)>(vb); H3 = tr_read<v_rd_off(D0, 3, 1)>(vb); } while (0)
#define PK(L, H) (bf16x8){L[0], L[1], L[2], L[3], H[0], H[1], H[2], H[3]}
#define PV_MMA(od, L0, H0, L1, H1, L2, H2, L3, H3) do { od = __builtin_amdgcn_mfma_f32_32x32x16_bf16(pa0, PK(L0, H0), od, 0, 0, 0); od = __builtin_amdgcn_mfma_f32_32x32x16_bf16(pa1, PK(L1, H1), od, 0, 0, 0); \
    od = __builtin_amdgcn_mfma_f32_32x32x16_bf16(pa2, PK(L2, H2), od, 0, 0, 0); od = __builtin_amdgcn_mfma_f32_32x32x16_bf16(pa3, PK(L3, H3), od, 0, 0, 0); } while (0)
DI void pv_d0(f32x16* o, int vb, bf16x8 pa0, bf16x8 pa1, bf16x8 pa2, bf16x8 pa3) {
    s16x4 a0, a1, a2, a3, a4, a5, a6, a7, b0, b1, b2, b3, b4, b5, b6, b7;
    PV_READS(0, a0, a1, a2, a3, a4, a5, a6, a7);
    PV_READS(1, b0, b1, b2, b3, b4, b5, b6, b7);
    asm volatile("s_waitcnt lgkmcnt(8)" ::: "memory"); SBAR();
    PV_MMA(o[0], a0, a1, a2, a3, a4, a5, a6, a7); SBAR();
    PV_READS(2, a0, a1, a2, a3, a4, a5, a6, a7);
    asm volatile("s_waitcnt lgkmcnt(8)" ::: "memory"); SBAR();
    PV_MMA(o[1], b0, b1, b2, b3, b4, b5, b6, b7); SBAR();
    PV_READS(3, b0, b1, b2, b3, b4, b5, b6, b7);
    asm volatile("s_waitcnt lgkmcnt(8)" ::: "memory"); SBAR();
    PV_MMA(o[2], a0, a1, a2, a3, a4, a5, a6, a7); SBAR();
    asm volatile("s_waitcnt lgkmcnt(0)" ::: "memory"); SBAR();
    PV_MMA(o[3], b0, b1, b2, b3, b4, b5, b6, b7);
}
#undef PV_READS
#undef PV_MMA
#undef PK

DI void attn_unit(const bf16_t* __restrict__ Qb, const bf16_t* __restrict__ Kn, const bf16_t* __restrict__ Kr, const bf16_t* __restrict__ Vh,
                  bf16_t* Ob, int seq, char* lds, int wv, const float* __restrict__ rope, int pos0) {
    const int tid = otid(wv), wid = tid >> 6, lane = tid & 63, r32 = lane & 31, hi = lane >> 5;
    char* V_lds = lds; char* K_lds = lds + NVS * SHM_V;
    float* ws = (float*)(lds + NVS * SHM_V + 2 * SHM_K) + wid * 64; float* li_l = ws; float* al_l = ws + 32;
    float m_reg = 0.f, l_reg = 0; f32x16 o[4]; bf16x8 qr[8]; f32x16 negm;
#pragma unroll
    for (int r = 0; r < 16; ++r) negm[r] = 0.f;
    char* qrl = lds + QR_OFF + wid * 4096 + lane * 16;
#pragma unroll
    for (int d = 0; d < 4; ++d)
#pragma unroll
        for (int r = 0; r < 16; ++r) o[d][r] = 0.f;
    const bf16_t* Qw = Qb + (size_t)(wid * QBLK + r32) * 1536 + hi * 8;
#pragma unroll
    for (int d0 = 0; d0 < 8; ++d0) qr[d0] = gld_bf8(Qw + d0 * 16);
#pragma unroll
    for (int d0 = 8; d0 < 12; ++d0) {
        const u32x4 raw = gld_u4(Qw + d0 * 16);
        const float* cs = rope + ((size_t)(pos0 + wid * QBLK + r32) * 32 + 4 * (2 * (d0 - 8) + hi)) * 2;
        const f32x4 ca = gld_f4(cs), cb = gld_f4(cs + 4);
        const float x10 = bf2f(raw.x & 0xffff), x11 = bf2f(raw.x >> 16), x12 = bf2f(raw.y & 0xffff), x13 = bf2f(raw.y >> 16);
        const float x20 = bf2f(raw.z & 0xffff), x21 = bf2f(raw.z >> 16), x22 = bf2f(raw.w & 0xffff), x23 = bf2f(raw.w >> 16);
        u32x4 w;
        w.x = cvt_pk_bf16(x10 * ca[0] - x20 * ca[1], x11 * ca[2] - x21 * ca[3]); w.y = cvt_pk_bf16(x12 * cb[0] - x22 * cb[1], x13 * cb[2] - x23 * cb[3]);
        w.z = cvt_pk_bf16(x20 * ca[0] + x10 * ca[1], x21 * ca[2] + x11 * ca[3]); w.w = cvt_pk_bf16(x22 * cb[0] + x12 * cb[1], x23 * cb[2] + x13 * cb[3]);
        *reinterpret_cast<u32x4*>(qrl + (d0 - 8) * 1024) = w; }
    const int sr = tid >> 4, sc = (tid & 15) * 8, vst0 = v_st(sr, sc), vst1 = v_st(32 + sr, sc);
    const int kr_ = tid >> 3, kc = (tid & 7) * 8;
    const int kst0 = KSWZ(kr_, kc * 2), kst1 = KSWZ(kr_, (64 + kc) * 2), kst2 = KSWZ(kr_, (128 + kc) * 2);
    const int vb0 = (int)(uintptr_t)V_lds + v_rd_base(lane);
    int kb[4];
#pragma unroll
    for (int i = 0; i < 4; ++i) kb[i] = KSWZ(r32, (i * 16 + hi * 8) * 2);
    bf16x8 vs0, vs1, ks0, ks1, ks2;
    const unsigned offV0 = (unsigned)(sr * 1024 + sc) * 2u, offK0 = (unsigned)(kr_ * 1024 + kc) * 2u, offR = (unsigned)(kr_ * 64 + kc) * 2u;
#define SLOAD(k0) do { const char* vt_ = (const char*)(Vh + (size_t)(k0) * 1024); const char* kt_ = (const char*)(Kn + (size_t)(k0) * 1024); const char* rt_ = (const char*)(Kr + (size_t)(k0) * 64); \
    vs0 = gld_bf8(vt_ + offV0); vs1 = gld_bf8(vt_ + offV0 + 65536u); \
    ks0 = gld_bf8(kt_ + offK0); ks1 = gld_bf8(kt_ + offK0 + 128u); \
    ks2 = gld_bf8(rt_ + offR); } while (0)
#define SWRITE(vo, ko) do { *(bf16x8*)(V_lds + (vo) + vst0) = vs0; *(bf16x8*)(V_lds + (vo) + vst1) = vs1; \
    *(bf16x8*)(K_lds + (ko) + kst0) = ks0; *(bf16x8*)(K_lds + (ko) + kst1) = ks1; *(bf16x8*)(K_lds + (ko) + kst2) = ks2; } while (0)
#define SWAIT() asm volatile("s_waitcnt vmcnt(0)" ::: "memory")
#define RESC(a) do { if (__any((a) < 1.f)) { if (hi == 0) al_l[r32] = (a); asm volatile("s_waitcnt lgkmcnt(0)" ::: "memory"); \
    _Pragma("unroll") for (int d = 0; d < 4; ++d) _Pragma("unroll") for (int r = 0; r < 16; ++r) o[d][r] *= al_l[crow(r, hi)]; } } while (0)
    f32x16 pA0, pA1; float alA; bf16x8 pa0, pa1, pa2, pa3; const int NT = seq / KVBLK;
    const bool grpB = (wv >= 4);
    int vcur = 0, kcur = 0;
    int vnxt = SHM_V, knxt = SHM_K;
#define STAGE_NEXT(jn) do { SWAIT(); SWRITE(vnxt, knxt); SBAR(); if ((jn) + 1 < NT) SLOAD(((jn) + 1) * KVBLK); SBAR(); asm volatile("s_waitcnt lgkmcnt(0)" ::: "memory"); __builtin_amdgcn_s_barrier(); SBAR(); } while (0)
    SLOAD(0); SWAIT(); SWRITE(0, 0); SBAR(); SLOAD(KVBLK); LDS_BARRIER();
    for (int j = 0; j < NT; ++j) {
        qkt(pA0, pA1, negm, K_lds + kcur, qr, qrl, kb); partialSM(pA0, pA1, m_reg, negm, alA, j == 0);
        RESC(alA);
        finishSM(pA0, pA1, alA, l_reg, pa0, pa1, pa2, pa3); SBAR();
        if (grpB && j + 1 < NT) STAGE_NEXT(j + 1);
        pv_d0(o, vb0 + vcur, pa0, pa1, pa2, pa3);
        SBAR();
        if (!grpB && j + 1 < NT) STAGE_NEXT(j + 1);
        vcur = vnxt; kcur = knxt; vnxt = (vnxt == (NVS - 1) * SHM_V) ? 0 : vnxt + SHM_V; knxt ^= SHM_K;
    }
#undef STAGE_NEXT
    if (hi == 0) li_l[r32] = l_reg; asm volatile("s_waitcnt lgkmcnt(0)" ::: "memory");
    bf16_t* Ow = Ob + (size_t)(wid * QBLK + 4 * hi) * 1536 + r32;
    asm volatile("" : "+v"(Ow));
#pragma unroll
    for (int r = 0; r < 16; ++r) { const int orow = crow(r, hi); const float rl = __builtin_amdgcn_rcpf(li_l[orow]);
        bf16_t* Or = Ow + ((r & 3) + 8 * (r >> 2)) * 1536;
#pragma unroll
        for (int d0 = 0; d0 < 4; ++d0) gst_h(Or + d0 * 32, f2bf(o[d0][r] * rl)); }
    LDS_BARRIER();
#undef SLOAD
#undef SWRITE
#undef SWAIT
#undef RESC
}
}

namespace fft {
DI s16x4 trr(unsigned addr) { s16x4 r; asm volatile("ds_read_b64_tr_b16 %0, %1" : "=&v"(r) : "v"(addr) : "memory"); return r; }
DI int crow(int r, int hi) { return (r & 3) + 8 * (r >> 2) + 4 * hi; }

template <int NN, int STAGE>
DI void fft_phase(char* lds, const bf16_t* __restrict__ src, bf16_t* __restrict__ dst, int nbatch, int G, int bid, int wv) {
    constexpr int S = NN * NN;
    constexpr int CW = (STAGE == 1) ? 256 : 128;
    constexpr int NCC = 1024 / CW;
    constexpr int KR = (STAGE == 1) ? NN : 2 * NN;
    constexpr int RS = CW * 2 + 64;
    constexpr int KS = KR / 16;
    constexpr int NROWT = NN / 16;
    constexpr int NCPART = 8 / NROWT;
    constexpr int NCBW = (CW / 32) / NCPART;
    constexpr int C16 = CW / 8;
    constexpr int NLD = KR * C16 / 512;
    const int tid = otid(wv), wid = tid >> 6, lane = tid & 63, m32 = lane & 31, h = lane >> 5;
    const int rt = wid % NROWT, cpart = wid / NROWT;
    const int nunits = nbatch * NN * NCC;
    bf16x8 areg[KS];
#pragma unroll
    for (int s = 0; s < KS; ++s) {
        float v[8];
#pragma unroll
        for (int j = 0; j < 8; ++j) { const int k = 16 * s + 8 * h + j;
            if (STAGE == 1) { const int c = 16 * rt + (m32 & 15), reim = m32 >> 4; const float fr = (float)((k * c) & (NN - 1)) * (1.0f / NN);
                v[j] = reim ? -sin2pi(fr) : cos2pi(fr); }
            else { const int R = 32 * rt + m32, ro = R / NN, d = R % NN, ri = k / NN, b = k % NN; const float fr = (float)((b * d) & (NN - 1)) * (1.0f / NN);
                const float cs = cos2pi(fr), sn = sin2pi(fr); v[j] = (ro == 0) ? (ri == 0 ? cs : sn) : (ri == 0 ? -sn : cs); } }
        u32x4 w = {cvt_pk_bf16(v[0], v[1]), cvt_pk_bf16(v[2], v[3]), cvt_pk_bf16(v[4], v[5]), cvt_pk_bf16(v[6], v[7])};
        areg[s] = *reinterpret_cast<bf16x8*>(&w);
    }
    const unsigned ldsb = (unsigned)(uintptr_t)lds;
    const int i16 = lane & 15, q = i16 >> 2, p = i16 & 3, blk = (lane >> 4) & 1;
    const unsigned rbase = ldsb + (unsigned)((8 * h + q) * RS + (16 * blk + 4 * p) * 2);
    u32x4 pre[NLD];
    auto unit_src = [&](int u, int& bt, int& x, int& cc) -> const bf16_t* {
        cc = u % NCC; const int t = u / NCC; x = t % NN; bt = t / NN;
        if (STAGE == 1) return src + ((size_t)bt * S + x) * 1024 + cc * CW;
        else return src + ((size_t)(bt * NN + x) * 2 * NN) * 1024 + cc * CW;
    };
    constexpr size_t ROWSTEP = (STAGE == 1) ? (size_t)NN * 1024 : 1024;
    int u = bid;
    if (u < nunits) { int bt, x, cc; const bf16_t* sp = unit_src(u, bt, x, cc);
#pragma unroll
        for (int i = 0; i < NLD; ++i) { const int ch = tid + i * 512, row = ch / C16, c16 = ch % C16; pre[i] = gld_u4(sp + (size_t)row * ROWSTEP + c16 * 8); } }
    for (; u < nunits; u += G) {
        int bt, x, cc; (void)unit_src(u, bt, x, cc);
        LDS_BARRIER();
#pragma unroll
        for (int i = 0; i < NLD; ++i) { const int ch = tid + i * 512, row = ch / C16, c16 = ch % C16; *(u32x4*)(lds + row * RS + c16 * 16) = pre[i]; }
        LDS_BARRIER();
        if (u + G < nunits) { int bt2, x2, cc2; const bf16_t* sp = unit_src(u + G, bt2, x2, cc2);
#pragma unroll
            for (int i = 0; i < NLD; ++i) { const int ch = tid + i * 512, row = ch / C16, c16 = ch % C16; pre[i] = gld_u4(sp + (size_t)row * ROWSTEP + c16 * 8); } }
        float tc[8], tsn[8];
        if (STAGE == 1) {
#pragma unroll
            for (int r = 0; r < 8; ++r) { const int c = 16 * rt + crow(r, h); const float fr = (float)((x * c) & (S - 1)) * (1.0f / S); tc[r] = cos2pi(fr); tsn[r] = sin2pi(fr); }
        }
#pragma unroll 1
        for (int cbi = 0; cbi < NCBW; ++cbi) {
            const int cb = cpart * NCBW + cbi;
            f32x16 acc;
#pragma unroll
            for (int r = 0; r < 16; ++r) acc[r] = 0.f;
            const unsigned cbase = rbase + (unsigned)(cb * 64);
#pragma unroll
            for (int s0 = 0; s0 < KS; s0 += 4) {
                s16x4 lo[4], hh[4];
#pragma unroll
                for (int i = 0; i < 4; ++i) { lo[i] = trr(cbase + (unsigned)((s0 + i) * 16 * RS)); hh[i] = trr(cbase + (unsigned)((s0 + i) * 16 * RS + 4 * RS)); }
                asm volatile("s_waitcnt lgkmcnt(0)" ::: "memory"); __builtin_amdgcn_sched_barrier(0);
#pragma unroll
                for (int i = 0; i < 4; ++i) { const bf16x8 bfr = (bf16x8){lo[i][0], lo[i][1], lo[i][2], lo[i][3], hh[i][0], hh[i][1], hh[i][2], hh[i][3]};
                    acc = __builtin_amdgcn_mfma_f32_32x32x16_bf16(areg[s0 + i], bfr, acc, 0, 0, 0); }
            }
            const int col = cc * CW + cb * 32 + m32;
            if (STAGE == 1) {
#pragma unroll
                for (int r = 0; r < 8; ++r) { const int c = 16 * rt + crow(r, h); const float tr_ = acc[r], ti = acc[r + 8];
                    const float o_r = tr_ * tc[r] + ti * tsn[r], o_i = ti * tc[r] - tr_ * tsn[r];
                    bf16_t* dp = dst + (((size_t)(bt * NN + c) * 2) * NN + x) * 1024 + col;
                    gst_h(dp, f2bf(o_r)); gst_h(dp + (size_t)NN * 1024, f2bf(o_i)); }
            } else {
#pragma unroll
                for (int r = 0; r < 16; ++r) { const int R = 32 * rt + crow(r, h), ro = R / NN, d = R % NN;
                    const size_t tok = (size_t)bt * S + x + (size_t)NN * d;
                    gst_h(dst + tok * 2048 + (col >> 8) * 512 + ro * 256 + (col & 255), f2bf(acc[r])); }
            }
        }
    }
    __syncthreads();
}
}

struct Args {
    const float* xp; const float* xs; const float* norm_g; const float* fnet_w; const float* fnet_b; const float* w_down; const float* q_norm; const float* w_uq;
    const float* kv_norm; const float* w_ukv; const float* w_o; const float* w_gate; const float* w_up; const float* w_fdown;
    float* out; unsigned char* ws; int ph_lo, ph_hi;
};

enum { JOB_FN = 0, JOB_DFT, JOB_DN, JOB_UQ, JOB_UKV, JOB_WO, JOB_GU, JOB_FD };
DI float prep_val(const Args& a, int job, int layer, int k, int n) {
    switch (job) {
    case JOB_FN: return a.fnet_w[(size_t)k * 1024 + n];
    case JOB_DFT: { const int ri = k >> 8, n2 = k & 255; const float fr = (float)((n2 * n) & 255) * (1.0f / 256); return ri ? sin2pi(fr) : cos2pi(fr); }
    case JOB_DN: return n < 576 ? a.norm_g[(4 + 0) * 1024 + k] * a.w_down[(size_t)k * 576 + n] : 0.f;
    case JOB_UQ: { const int hh = n / 192, c = n % 192; int sc = c; if (c >= 128) { const int p = c - 128; sc = 128 + 32 * ((p >> 2) & 1) + 4 * (p >> 3) + (p & 3); }
        return a.q_norm[k] * a.w_uq[(size_t)k * 1536 + hh * 192 + sc] * QSCALE; }
    case JOB_UKV: return a.kv_norm[k] * a.w_ukv[(size_t)k * 2048 + n];
    case JOB_WO: return a.w_o[(size_t)k * 1024 + n];
    case JOB_GU: { const int pn = n >> 8, isup = (n >> 7) & 1, col = pn * 128 + (n & 127); const float* w = (isup ? a.w_up : a.w_gate) + (size_t)layer * 1024 * DFF;
        return a.norm_g[(layer * 4 + 2) * 1024 + k] * w[(size_t)k * DFF + col]; }
    default: return a.w_fdown[(size_t)layer * DFF * 1024 + (size_t)k * 1024 + n];
    }
}
DI void prep_job(const Args& a, int job, int layer, int N, int K, bf16_t* dst, float* scr, int item0, int& item_base, int G, int bid, int wv) {
    const int tn = N / 64, tk = K / 64, n_items = tn * tk, tid = otid(wv);
    int first = item_base; item_base += n_items;
    int i = bid - (first % G); if (i < 0) i += G;
    for (; i < n_items; i += G) {
        const int n0 = (i % tn) * 64, k0 = (i / tn) * 64;
        __syncthreads();
#pragma unroll
        for (int e8 = 0; e8 < 8; ++e8) { const int e = tid + e8 * 512, kk = e >> 6, nn = e & 63; scr[nn * 65 + kk] = prep_val(a, job, layer, k0 + kk, n0 + nn); }
        __syncthreads();
#pragma unroll
        for (int e4 = 0; e4 < 4; ++e4) { const int e = tid + e4 * 512, nn = e >> 5, k2 = (e & 31) * 2;
            *(unsigned*)(dst + (size_t)(n0 + nn) * K + k0 + k2) = cvt_pk_bf16(scr[nn * 65 + k2], scr[nn * 65 + k2 + 1]); }
    }
    (void)item0;
}

DI void row_first(const Args& a, bf16_t* H, int G, int bid, int wv) {
    const int tid_ = otid(wv), wid = tid_ >> 6, lane = tid_ & 63;
    const float* g = a.norm_g;
    for (int row = bid * 8 + wid; row < T_ALL; row += G * 8) {
        const float* xr = row < T_HALF ? a.xp + (size_t)row * 1024 : a.xs + (size_t)(row - T_HALF) * 1024;
        f32x4 x[4]; float ss = 0.f;
#pragma unroll
        for (int hv = 0; hv < 2; ++hv) { x[2 * hv] = *(const f32x4*)(xr + hv * 512 + lane * 8); x[2 * hv + 1] = *(const f32x4*)(xr + hv * 512 + lane * 8 + 4); }
#pragma unroll
        for (int i = 0; i < 4; ++i)
#pragma unroll
            for (int j = 0; j < 4; ++j) ss += x[i][j] * x[i][j];
        ss = wave_sum(ss); const float r = rsqrtf(ss * (1.0f / 1024) + NORM_EPS);
#pragma unroll
        for (int hv = 0; hv < 2; ++hv) { const int c = hv * 512 + lane * 8; const f32x4 g0 = *(const f32x4*)(g + c), g1 = *(const f32x4*)(g + c + 4);
            const f32x4 y0 = x[2 * hv] * r * g0, y1 = x[2 * hv + 1] * r * g1;
            u32x4 w = {cvt_pk_bf16(y0[0], y0[1]), cvt_pk_bf16(y0[2], y0[3]), cvt_pk_bf16(y1[0], y1[1]), cvt_pk_bf16(y1[2], y1[3])};
            *(u32x4*)(H + (size_t)row * 1024 + c) = w; }
    }
}
DI void row_mid(const bf16_t* m, const float* gpost, const float* xf0, const float* xf1, const bf16_t* xb_in, bf16_t* xb_out, float* rs_out, float* out_f, int G, int bid, int wv) {
    const int tid_ = otid(wv), wid = tid_ >> 6, lane = tid_ & 63;
    constexpr int NR = 2;
    for (int row0 = bid * 8 + wid; row0 < T_ALL; row0 += G * 8 * NR) {
        f32x4 x[NR][4]; u32x4 mw[NR][2];
#pragma unroll
        for (int q = 0; q < NR; ++q) { const int row = min(row0 + q * G * 8, T_ALL - 1);
#pragma unroll
            for (int hv = 0; hv < 2; ++hv) { const int c = hv * 512 + lane * 8;
                if (xb_in) { const u32x4 w = gld_u4(xb_in + (size_t)row * 1024 + c);
                    x[q][2 * hv] = (f32x4){bf2f(w.x & 0xffff), bf2f(w.x >> 16), bf2f(w.y & 0xffff), bf2f(w.y >> 16)};
                    x[q][2 * hv + 1] = (f32x4){bf2f(w.z & 0xffff), bf2f(w.z >> 16), bf2f(w.w & 0xffff), bf2f(w.w >> 16)}; }
                else { const float* xr = row < T_HALF ? xf0 + (size_t)row * 1024 : xf1 + (size_t)(row - T_HALF) * 1024;
                    x[q][2 * hv] = gld_f4(xr + c); x[q][2 * hv + 1] = gld_f4(xr + c + 4); }
                mw[q][hv] = gld_u4(m + (size_t)row * 1024 + c); } }
#pragma unroll
        for (int q = 0; q < NR; ++q) { const int row = row0 + q * G * 8; if (row >= T_ALL) continue;
            f32x4 mv[4]; float ss = 0.f;
#pragma unroll
            for (int hv = 0; hv < 2; ++hv) { const u32x4 w = mw[q][hv];
                mv[2 * hv] = (f32x4){bf2f(w.x & 0xffff), bf2f(w.x >> 16), bf2f(w.y & 0xffff), bf2f(w.y >> 16)};
                mv[2 * hv + 1] = (f32x4){bf2f(w.z & 0xffff), bf2f(w.z >> 16), bf2f(w.w & 0xffff), bf2f(w.w >> 16)}; }
#pragma unroll
            for (int i = 0; i < 4; ++i)
#pragma unroll
                for (int j = 0; j < 4; ++j) ss += mv[i][j] * mv[i][j];
            ss = wave_sum(ss); const float r1 = rsqrtf(ss * (1.0f / 1024) + NORM_EPS);
            float s2 = 0.f;
#pragma unroll
            for (int hv = 0; hv < 2; ++hv) { const int c = hv * 512 + lane * 8; const f32x4 g0 = gld_f4(gpost + c), g1 = gld_f4(gpost + c + 4);
                x[q][2 * hv] = x[q][2 * hv] + mv[2 * hv] * r1 * g0; x[q][2 * hv + 1] = x[q][2 * hv + 1] + mv[2 * hv + 1] * r1 * g1;
                if (out_f) { gst_f4(out_f + (size_t)row * 1024 + c, x[q][2 * hv]); gst_f4(out_f + (size_t)row * 1024 + c + 4, x[q][2 * hv + 1]); }
                else { const f32x4 y0 = x[q][2 * hv], y1 = x[q][2 * hv + 1];
                    u32x4 w = {cvt_pk_bf16(y0[0], y0[1]), cvt_pk_bf16(y0[2], y0[3]), cvt_pk_bf16(y1[0], y1[1]), cvt_pk_bf16(y1[2], y1[3])};
                    gst_u4(xb_out + (size_t)row * 1024 + c, w); } }
            if (rs_out) {
#pragma unroll
                for (int i = 0; i < 4; ++i)
#pragma unroll
                    for (int j = 0; j < 4; ++j) s2 += x[q][i][j] * x[q][i][j];
                s2 = wave_sum(s2); if (lane == 0) rs_out[row] = rsqrtf(s2 * (1.0f / 1024) + NORM_EPS);
            }
        }
    }
}
DI void row_mla(const bf16_t* down, const float* rope, bf16_t* cq, bf16_t* ckv, bf16_t* kr, int G, int bid, int wv) {
    const int tid_ = otid(wv), wid = tid_ >> 6, lane = tid_ & 63;
    for (int row = bid * 8 + wid; row < T_ALL; row += G * 8) {
        const bf16_t* dr = down + (size_t)row * 768;
        const u32x2 a = *(const u32x2*)(dr + lane * 4), b = *(const u32x2*)(dr + 256 + lane * 4);
        const float a0 = bf2f(a.x & 0xffff), a1 = bf2f(a.x >> 16), a2 = bf2f(a.y & 0xffff), a3 = bf2f(a.y >> 16);
        const float b0 = bf2f(b.x & 0xffff), b1 = bf2f(b.x >> 16), b2 = bf2f(b.y & 0xffff), b3 = bf2f(b.y >> 16);
        const float sa = wave_sum(a0 * a0 + a1 * a1 + a2 * a2 + a3 * a3), sb = wave_sum(b0 * b0 + b1 * b1 + b2 * b2 + b3 * b3);
        const float ra = rsqrtf(sa * (1.0f / 256) + NORM_EPS), rb = rsqrtf(sb * (1.0f / 256) + NORM_EPS);
        u32x2 wa = {cvt_pk_bf16(a0 * ra, a1 * ra), cvt_pk_bf16(a2 * ra, a3 * ra)}, wb = {cvt_pk_bf16(b0 * rb, b1 * rb), cvt_pk_bf16(b2 * rb, b3 * rb)};
        *(u32x2*)(cq + (size_t)row * 256 + lane * 4) = wa; *(u32x2*)(ckv + (size_t)row * 256 + lane * 4) = wb;
        const float xv = bf2f(dr[512 + lane]); const float xo = __shfl_xor(xv, 32);
        const int pos = row < T_HALF ? (row & (S_P - 1)) : (row & (S_S - 1)); const int i = lane & 31;
        const float cs = rope[((size_t)pos * 32 + i) * 2], sn = rope[((size_t)pos * 32 + i) * 2 + 1];
        const float ov = lane < 32 ? (xv * cs - xo * sn) : (xv * cs + xo * sn);
        const int pidx = 8 * (i >> 2) + 4 * (lane >> 5) + (i & 3);
        kr[(size_t)row * 64 + pidx] = f2bf(ov);
    }
}


#define XB_TMO      128
#define XB_XCNT(j)  (256  + 64 * (j))
#define XB_XSUB(j)  (1280 + 64 * (j))
#define XB_XGEN(j)  (2304 + 64 * (j))
#define XB_TOP      3328
#define XB_TOPGEN   3392
#define XB_SPIN_CAP (1u << 22)
DI unsigned xb_ld(unsigned* p)              { return __hip_atomic_load(p, __ATOMIC_RELAXED, __HIP_MEMORY_SCOPE_AGENT); }
DI unsigned xb_add(unsigned* p, unsigned v) { return __hip_atomic_fetch_add(p, v, __ATOMIC_RELAXED, __HIP_MEMORY_SCOPE_AGENT); }
DI unsigned xb_xcc_id() { return (unsigned)__builtin_amdgcn_s_getreg((3 << 11) | 20) & 0xFu; }
#define XB_SPIN(cond, bar) do { unsigned _sp = 0; while (cond) { __builtin_amdgcn_s_sleep(1); \
    if ((++_sp & 255u) == 0u) { if (xb_ld(&(bar)[XB_TMO])) break; if (_sp > XB_SPIN_CAP) { atomicAdd(&(bar)[XB_TMO], 1u); break; } } } } while (0)
struct XcdBarrier { unsigned* bar; unsigned x; volatile LAS unsigned* st; };
DI void xcd_barrier_complete(unsigned* bar, unsigned x, unsigned& nloc, unsigned& nx) {
    const unsigned G = gridDim.x;
    unsigned sum, cnt, mine, sp = 0u;
    for (;;) {
        sum = 0u; cnt = 0u; mine = 0u;
#pragma unroll
        for (unsigned j = 0; j < 16; ++j) { const unsigned c = xb_ld(&bar[XB_XCNT(j)]); sum += c; cnt += (c > 0u) ? 1u : 0u; mine = (j == x) ? c : mine; }
        if (sum == G) break;
        __builtin_amdgcn_s_sleep(1);
        if ((++sp & 255u) == 0u) { if (xb_ld(&bar[XB_TMO])) break; if (sp > XB_SPIN_CAP) { atomicAdd(&bar[XB_TMO], 1u); break; } }
    }
    nloc = mine > 0u ? mine : 1u; nx = cnt > 0u ? cnt : 1u;
}
DI void xcd_barrier(const XcdBarrier& b, int wv) {
    asm volatile("s_waitcnt vmcnt(0)" ::: "memory");
    __syncthreads();
    if (otid(wv) == 0) {
        unsigned* bar = b.bar;
        __builtin_amdgcn_s_waitcnt(0);
        unsigned nloc = b.st[0], nx = b.st[1];
        if (nloc == 0u) { xcd_barrier_complete(bar, b.x, nloc, nx); b.st[0] = nloc; b.st[1] = nx; }
        const unsigned old = xb_add(&bar[XB_XSUB(b.x)], 1u);
        const unsigned gen = old / nloc;
        if (old + 1u == (gen + 1u) * nloc) {
            __builtin_amdgcn_fence(__ATOMIC_RELEASE, "agent");
            asm volatile("s_waitcnt vmcnt(0)" ::: "memory");
            const unsigned og = xb_add(&bar[XB_TOP], 1u);
            const unsigned tg = og / nx;
            if (og + 1u == (tg + 1u) * nx) xb_add(&bar[XB_TOPGEN], 1u);
            else XB_SPIN(xb_ld(&bar[XB_TOPGEN]) == tg, bar);
            __builtin_amdgcn_fence(__ATOMIC_ACQUIRE, "agent");
            xb_add(&bar[XB_XGEN(b.x)], 1u);
            asm volatile("s_waitcnt vmcnt(0)" ::: "memory");
        } else {
            XB_SPIN(xb_ld(&bar[XB_XGEN(b.x)]) == gen, bar);
            __builtin_amdgcn_fence(__ATOMIC_ACQUIRE, "agent");
            asm volatile("s_waitcnt vmcnt(0)" ::: "memory");
        }
    }
    __syncthreads();
}

constexpr int LDS_BYTES = 147456;
constexpr int LDS_BAR_OFF = LDS_BYTES - 64;
constexpr int NPHASE = 27;

DI unsigned char* opq(unsigned char* p) { asm volatile("" : "+s"(p)); return (unsigned char*)(__attribute__((address_space(1))) unsigned char*)p; }
__global__ void __launch_bounds__(512, 2) mega(Args a) {
    extern __shared__ __attribute__((aligned(16))) unsigned char lds[];
    cg::grid_group grid = cg::this_grid();
    const int G = gridDim.x, bid = blockIdx.x, wv = __builtin_amdgcn_readfirstlane((int)threadIdx.x >> 6);
    const int lo = a.ph_lo, hi = a.ph_hi;
#ifndef PHMASK
#define PHMASK 0xFFFFFFFFu
#endif
#define IN(k) ((((PHMASK) >> (k)) & 1u) && lo <= (k) && (k) < hi)
    XcdBarrier xbar; xbar.bar = (unsigned*)a.ws; xbar.x = xb_xcc_id(); xbar.st = (volatile LAS unsigned*)((LAS unsigned char*)lds + LDS_BAR_OFF);
    if (threadIdx.x < 2) xbar.st[threadIdx.x] = 0u;
    if (threadIdx.x == 0) (void)xb_add(&xbar.bar[XB_XCNT(xbar.x)], 1u);
    __syncthreads();
    if (lo < 0) grid.sync();
#define SYNC(k) do { if (lo <= (k) && (k) + 1 < hi) xcd_barrier(xbar, wv); } while (0)
#define WSB(off) ((bf16_t*)(opq(a.ws) + (off)))
#define LDSL ((LAS unsigned char*)lds)
#ifndef NREP
#define NREP 1
#endif
#define REP for (int rep_ = 0; rep_ < NREP; ++rep_)

    if (IN(0)) REP {
        int ib = 0; float* scr = (float*)lds;
        prep_job(a, JOB_FN, 0, 1024, 1024, WSB(WS_WFN), scr, 0, ib, G, bid, wv);
        prep_job(a, JOB_DFT, 0, 256, 512, WSB(WS_DFT), scr, 0, ib, G, bid, wv);
        prep_job(a, JOB_DN, 0, 768, 1024, WSB(WS_WDN), scr, 0, ib, G, bid, wv);
        prep_job(a, JOB_UQ, 0, 1536, 256, WSB(WS_WUQ), scr, 0, ib, G, bid, wv);
        prep_job(a, JOB_UKV, 0, 2048, 256, WSB(WS_WUKV), scr, 0, ib, G, bid, wv);
        prep_job(a, JOB_WO, 0, 1024, 1024, WSB(WS_WO), scr, 0, ib, G, bid, wv);
        prep_job(a, JOB_GU, 0, 5632, 1024, WSB(WS_WGU), scr, 0, ib, G, bid, wv);
        prep_job(a, JOB_FD, 0, 1024, 2816, WSB(WS_WFD), scr, 0, ib, G, bid, wv);
        float* rope = (float*)WSB(WS_ROPE);
        for (int e = bid * 512 + otid(wv); e < 16384 * 32; e += G * 512) { const int pos = e >> 5, i = e & 31;
            const float inv = 1.0f / powf(10000.0f, (float)(2 * i) / 64.0f); const float ang = (float)pos * inv;
            const double rev = (double)ang * 0.15915494309189535; const float fr = (float)(rev - floor(rev));
            rope[(size_t)e * 2] = cos2pi(fr); rope[(size_t)e * 2 + 1] = sin2pi(fr); }
        row_first(a, WSB(WS_H), G, bid, wv);
    }
    SYNC(0);
    if (IN(1)) REP fft::fft_phase<128, 1>((char*)lds, WSB(WS_H), WSB(WS_TP), 2, G, bid, wv);
    SYNC(1);
    if (IN(2)) REP fft::fft_phase<128, 2>((char*)lds, WSB(WS_TP), WSB(WS_PQ), 2, G, bid, wv);
    SYNC(2);
    if (IN(3)) REP { pg8::Gemm g{WSB(WS_PQ), WSB(WS_DFT), T_HALF, 1024, 512, 2048, 1024, 1, 0}; pg8::StaticOrder S; S.init(T_HALF, 1024, G, bid);
        pg8::EpiStore E{WSB(WS_H), 1024, nullptr, nullptr}; pg8::gemm_phase(LDSL, g, S, E, wv); }
    if (IN(4)) REP fft::fft_phase<64, 1>((char*)lds, WSB(WS_H) + (size_t)T_HALF * 1024, WSB(WS_TP), 8, G, bid, wv);
    SYNC(4);
    if (IN(5)) REP fft::fft_phase<64, 2>((char*)lds, WSB(WS_TP), WSB(WS_PQ), 8, G, bid, wv);
    SYNC(5);
    if (IN(6)) REP { pg8::Gemm g{WSB(WS_PQ), WSB(WS_DFT), T_HALF, 1024, 512, 2048, 1024, 1, 0}; pg8::StaticOrder S; S.init(T_HALF, 1024, G, bid);
        pg8::EpiStore E{WSB(WS_H) + (size_t)T_HALF * 1024, 1024, nullptr, nullptr}; pg8::gemm_phase(LDSL, g, S, E, wv); }
    SYNC(6);
    if (IN(7)) REP { pg8::Gemm g{WSB(WS_H), WSB(WS_WFN), T_ALL, 1024, 1024, 1024, 0, 0, 0}; pg8::StaticOrder S; S.init(T_ALL, 1024, G, bid);
        pg8::EpiStore E{WSB(WS_M), 1024, a.fnet_b, nullptr}; pg8::gemm_phase(LDSL, g, S, E, wv); }
    SYNC(7);
    if (IN(8)) REP row_mid(WSB(WS_M), a.norm_g + 1 * 1024, a.xp, a.xs, nullptr, (bf16_t*)a.out, (float*)WSB(WS_RSTD), nullptr, G, bid, wv);
    SYNC(8);
#define FFN_PHASES(base, layer, last) \
    for (int hf = 0; hf < 2; ++hf) { \
        if (IN((base) + 2 * hf)) REP { const bf16_t* xres = (layer) ? (const bf16_t*)WSB(WS_H) : (const bf16_t*)a.out;     \
            pg8::Gemm g{xres + (size_t)hf * T_HALF * 1024, WSB(WS_WGU), T_HALF, 5632, 1024, 1024, 0, 0, 0}; pg8::StaticOrder S; S.init(T_HALF, 5632, G, bid); \
            pg8::EpiSwiGLU E{WSB(WS_ACT), (const float*)WSB(WS_RSTD) + (size_t)hf * T_HALF}; pg8::gemm_phase(LDSL, g, S, E, wv); } \
        SYNC((base) + 2 * hf); \
        if (IN((base) + 2 * hf + 1)) REP { pg8::Gemm g{WSB(WS_ACT), WSB(WS_WFD), T_HALF, 1024, DFF, DFF, 0, 0, 0}; pg8::StaticOrder S; S.init(T_HALF, 1024, G, bid); \
            pg8::EpiStore E{WSB(WS_F) + (size_t)hf * T_HALF * 1024, 1024, nullptr, nullptr}; pg8::gemm_phase(LDSL, g, S, E, wv); } \
        SYNC((base) + 2 * hf + 1); \
    } \
    if (IN((base) + 4)) { if (last) row_mid(WSB(WS_F), a.norm_g + ((layer) * 4 + 3) * 1024, nullptr, nullptr, WSB(WS_H), nullptr, nullptr, a.out, G, bid, wv); \
                          else row_mid(WSB(WS_F), a.norm_g + ((layer) * 4 + 3) * 1024, nullptr, nullptr, (const bf16_t*)a.out, (bf16_t*)a.out, (float*)WSB(WS_RSTD), nullptr, G, bid, wv); } \
    SYNC((base) + 4);
#pragma unroll 1
    for (int layer = 0; layer < 2; ++layer) {
        const int base = layer ? 22 : 9;
        if (layer == 1) {
            if (IN(14)) REP { pg8::Gemm g{(const bf16_t*)a.out, WSB(WS_WDN), T_ALL, 768, 1024, 1024, 0, 0, 0}; pg8::StaticOrder S; S.init(T_ALL, 768, G, bid);
                pg8::EpiStore E{WSB(WS_DOWN), 768, nullptr, (const float*)WSB(WS_RSTD)}; pg8::gemm_phase(LDSL, g, S, E, wv); }
            SYNC(14);
            if (IN(15)) REP {
                row_mla(WSB(WS_DOWN), (const float*)WSB(WS_ROPE), WSB(WS_CQ), WSB(WS_CKV), WSB(WS_KR), G, bid, wv);
                int ib = 0; float* scr = (float*)lds;
                prep_job(a, JOB_GU, 1, 5632, 1024, WSB(WS_WGU), scr, 0, ib, G, bid, wv);
                prep_job(a, JOB_FD, 1, 1024, 2816, WSB(WS_WFD), scr, 0, ib, G, bid, wv);
                __syncthreads();
            }
            SYNC(15);
            if (IN(16)) REP { pg8::Gemm g{WSB(WS_CQ), WSB(WS_WUQ), T_ALL, 1536, 256, 256, 0, 0, 0}; pg8::StaticOrder S; S.init(T_ALL, 1536, G, bid);
                pg8::EpiStore E{WSB(WS_Q), 1536, nullptr, nullptr}; pg8::gemm_phase(LDSL, g, S, E, wv); }
#define KN_OF(hf) ((hf) ? (bf16_t*)((unsigned char*)a.out + 128 * MiB) : WSB(WS_KN))
#define V_OF(hf)  ((hf) ? (bf16_t*)((unsigned char*)a.out + 192 * MiB) : WSB(WS_V))
#pragma unroll 1
            for (int hf = 0; hf < 2; ++hf) {
                if (IN(16)) REP { pg8::Gemm g{WSB(WS_CKV) + (size_t)hf * T_HALF * 256, WSB(WS_WUKV), T_HALF, 2048, 256, 256, 0, 0, 0}; pg8::StaticOrder S; S.init(T_HALF, 2048, G, bid);
                    pg8::EpiKV E{KN_OF(hf), V_OF(hf)}; pg8::gemm_phase(LDSL, g, S, E, wv); }
            }
            SYNC(16);
            if (IN(17)) {
#pragma unroll 1
                for (int hf = 0; hf < 2; ++hf) {
                    const int xcd = bid & 7, slot = bid >> 3;
                    for (int it = 0; it * G < 1024; ++it) {
                        int combo, qb;
                        if (G == 256) { if (hf == 0) { combo = it * 4 + (xcd >> 1); qb = (xcd & 1) * 32 + slot; } else { combo = it * 16 + xcd * 2 + (slot >> 4); qb = slot & 15; } }
                        else { const int u = it * G + bid; if (u >= 1024) break; if (hf == 0) { combo = u >> 6; qb = u & 63; } else { combo = u >> 4; qb = u & 15; } }
                        const int bt = combo >> 3, hh = combo & 7; const int seq = hf ? S_S : S_P;
                        const size_t tloc = (size_t)bt * seq, tglob = (size_t)hf * T_HALF + tloc;
                        bf16_t* qp = WSB(WS_Q) + (tglob + (size_t)qb * 256) * 1536 + hh * 192;
                        att::attn_unit(qp, KN_OF(hf) + tloc * 1024 + hh * 128, WSB(WS_KR) + tglob * 64, V_OF(hf) + tloc * 1024 + hh * 128, qp, seq, (char*)lds, wv, (const float*)WSB(WS_ROPE), qb * 256);
                    }
                }
            }
            SYNC(17);
#undef KN_OF
#undef V_OF
            if (IN(20)) REP { pg8::Gemm g{WSB(WS_Q), WSB(WS_WO), T_ALL, 1024, 1024, 1536, 0, 0, 1}; pg8::StaticOrder S; S.init(T_ALL, 1024, G, bid);
                pg8::EpiStore E{WSB(WS_M2), 1024, nullptr, nullptr}; pg8::gemm_phase(LDSL, g, S, E, wv); }
            SYNC(20);
            if (IN(21)) row_mid(WSB(WS_M2), a.norm_g + (4 + 1) * 1024, nullptr, nullptr, (const bf16_t*)a.out, WSB(WS_H), (float*)WSB(WS_RSTD), nullptr, G, bid, wv);
            SYNC(21);
        }
        FFN_PHASES(base, layer, layer == 1)
    }
#ifdef DBG_OFF
    if (hi >= 27) { grid.sync(); const bf16_t* sp = WSB(DBG_OFF);
        for (size_t i = (size_t)bid * 512 + otid(wv); i < (size_t)T_ALL * 1024; i += (size_t)G * 512) a.out[i] = bf2f(sp[i]); }
#endif
#undef IN
#undef SYNC
}

extern "C" void kernel_launch(void* const* d_in, const int* in_sizes, int n_in, void* d_out, int out_size, void* d_ws, size_t ws_size, hipStream_t stream) {
    static int grid = 0;
    if (grid == 0) {
        if (n_in != 14 || out_size != T_ALL * DM || ws_size < WS_END) { fprintf(stderr, "kernel_launch: unexpected shapes (n_in %d out %d ws %zu)\n", n_in, out_size, ws_size); grid = -1; return; }
        int dev = 0, cus = 0, per_cu = 0;
        (void)hipGetDevice(&dev); (void)hipDeviceGetAttribute(&cus, hipDeviceAttributeMultiprocessorCount, dev);
        if (hipFuncSetAttribute((const void*)mega, hipFuncAttributeMaxDynamicSharedMemorySize, LDS_BYTES) != hipSuccess) { fprintf(stderr, "kernel_launch: hipFuncSetAttribute failed\n"); grid = -1; return; }
        (void)hipOccupancyMaxActiveBlocksPerMultiprocessor(&per_cu, (const void*)mega, 512, LDS_BYTES);
        (void)hipGetLastError();
        if (per_cu < 1) per_cu = 1;
        grid = cus * 1;
    }
    if (grid < 0) return;
    Args a{};
    a.xp = (const float*)d_in[0]; a.xs = (const float*)d_in[1]; a.norm_g = (const float*)d_in[2]; a.fnet_w = (const float*)d_in[3]; a.fnet_b = (const float*)d_in[4];
    a.w_down = (const float*)d_in[5]; a.q_norm = (const float*)d_in[6]; a.w_uq = (const float*)d_in[7]; a.kv_norm = (const float*)d_in[8]; a.w_ukv = (const float*)d_in[9];
    a.w_o = (const float*)d_in[10]; a.w_gate = (const float*)d_in[11]; a.w_up = (const float*)d_in[12]; a.w_fdown = (const float*)d_in[13];
    a.out = (float*)d_out; a.ws = (unsigned char*)d_ws; a.ph_lo = 0; a.ph_hi = NPHASE;
    if (hipMemsetAsync(d_ws, 0, 16384, stream) != hipSuccess) { fprintf(stderr, "kernel_launch: memset failed\n"); return; }
    void* args[] = {&a};
    hipError_t e = hipLaunchCooperativeKernel((const void*)mega, dim3(grid), dim3(512), args, LDS_BYTES, stream);
    if (e != hipSuccess) fprintf(stderr, "cooperative launch failed: %s (grid %d)\n", hipGetErrorString(e), grid);
}
```

```cpp
#include <hip/hip_runtime.h>
#include <hip/hip_cooperative_groups.h>
#include <cstdint>
#include <cstdio>
namespace cg = cooperative_groups;

#define DI __device__ __forceinline__
#define LAS __attribute__((address_space(3)))
typedef unsigned short bf16_t;
typedef short bf16x8 __attribute__((ext_vector_type(8)));
typedef short s16x4 __attribute__((ext_vector_type(4)));
typedef float f32x4 __attribute__((ext_vector_type(4)));
typedef float f32x16 __attribute__((ext_vector_type(16)));
typedef unsigned u32x4 __attribute__((ext_vector_type(4)));
typedef unsigned u32x2 __attribute__((ext_vector_type(2)));

constexpr int T_ALL = 65536, T_HALF = 32768, DM = 1024, DFF = 2816;
constexpr int S_P = 16384, S_S = 4096;
constexpr float NORM_EPS = 1e-6f;
constexpr float QSCALE = 0.07216878364870322f * 1.4426950408889634f;

constexpr size_t MiB = 1u << 20;
constexpr size_t WS_ROPE = 1 * MiB;
constexpr size_t WS_WFN  = 5 * MiB;
constexpr size_t WS_DFT  = 7 * MiB;
constexpr size_t WS_WDN  = 7 * MiB + 512 * 1024;
constexpr size_t WS_WUQ  = 9 * MiB;
constexpr size_t WS_WUKV = 10 * MiB;
constexpr size_t WS_WO   = 11 * MiB;
constexpr size_t WS_WGU  = 14 * MiB;
constexpr size_t WS_WFD  = 25 * MiB;
constexpr size_t WS_RSTD = 31 * MiB;
constexpr size_t WS_H    = 32 * MiB;
constexpr size_t WS_G    = 160 * MiB;
constexpr size_t WS_TP   = WS_G;
constexpr size_t WS_PQ   = WS_G + 128 * MiB;
constexpr size_t WS_M    = WS_G;
constexpr size_t WS_ACT  = WS_G;
constexpr size_t WS_F    = WS_G + 176 * MiB;
constexpr size_t WS_DOWN = WS_G;
constexpr size_t WS_CQ   = WS_G + 96 * MiB;
constexpr size_t WS_CKV  = WS_G + 128 * MiB;
constexpr size_t WS_KR   = WS_G + 160 * MiB;
constexpr size_t WS_Q    = 32 * MiB;
constexpr size_t WS_KN   = WS_G + 176 * MiB;
constexpr size_t WS_V    = WS_G + 240 * MiB;
constexpr size_t WS_M2   = WS_G + 176 * MiB;
constexpr size_t WS_END  = 464 * MiB;

DI int otid(int wv) { int l; asm volatile("v_mbcnt_lo_u32_b32 %0, -1, 0\n\tv_mbcnt_hi_u32_b32 %0, -1, %0" : "=v"(l)); return wv * 64 + l; }
typedef float f32x2_t __attribute__((ext_vector_type(2)));
typedef __bf16 bf16x2_t __attribute__((ext_vector_type(2)));
DI unsigned cvt_pk_bf16(float lo, float hi) { const f32x2_t v = {lo, hi}; const bf16x2_t b = __builtin_convertvector(v, bf16x2_t); return __builtin_bit_cast(unsigned, b); }
DI bf16_t f2bf(float x) { return (bf16_t)(cvt_pk_bf16(x, x) & 0xffffu); }
DI float bf2f(unsigned b) { return __uint_as_float(b << 16); }
DI float wave_sum(float v) {
#pragma unroll
    for (int o = 1; o < 64; o <<= 1) v += __shfl_xor(v, o);
    return v;
}
#define GAS __attribute__((address_space(1)))
DI bf16x8 gld_bf8(const void* p) { return *(const GAS bf16x8*)p; }
DI u32x4 gld_u4(const void* p) { return *(const GAS u32x4*)p; }
DI f32x4 gld_f4(const void* p) { return *(const GAS f32x4*)p; }
DI void gst_u4(void* p, u32x4 v) { *(GAS u32x4*)p = v; }
DI void gst_u2(void* p, u32x2 v) { *(GAS u32x2*)p = v; }
DI void gst_f4(void* p, f32x4 v) { *(GAS f32x4*)p = v; }
DI void gst_h(void* p, bf16_t v) { *(GAS bf16_t*)p = v; }
DI float cos2pi(float frac) { return __builtin_amdgcn_cosf(frac); }
DI float sin2pi(float frac) { return __builtin_amdgcn_sinf(frac); }

namespace pg8 {
constexpr int BM = 256, BK = 64, HALF = 128, HTB = HALF * BK * 2, STAGE_BYTES = 8 * HTB, NXCD = 8, WGM = 8;
DI int lds_byte(int r, int c) { const int st = (r >> 4) * 2 + (c >> 5), rr = r & 15, cc = c & 31, ob = rr * 64 + cc * 2; return st * 1024 + (ob ^ (((ob >> 9) & 1) << 5)); }
DI void stage_rc(int b, int& R, int& C) { const int st = b / 1024, sb = b % 1024, swz = sb ^ (((sb >> 9) & 1) << 5); R = (st >> 1) * 16 + swz / 64; C = (st & 1) * 32 + (swz % 64) / 2; }
DI int perm32(int rho) { const int n = rho >> 4, i = rho & 15; return 8 * (i >> 2) + 4 * n + (i & 3); }

struct Unit { int pm, pn; };
struct Gemm { const bf16_t* A; const bf16_t* Bt; int M, N, K, lda; long a_pn_off; int b_shared; int askip; };

struct StaticOrder {
    int nM, nN, nwg, G, c;
    DI void init(int M, int N, int G_, int c_) { nM = M / BM; nN = N / BM; nwg = nM * nN; G = G_; c = c_; }
    DI bool next(int i, Unit& u) const {
        const long L = (long)i * G + c; if (L >= nwg) return false;
        int wgid = (int)L; { const int q = nwg / NXCD, r = nwg % NXCD, xcd = wgid % NXCD, off = wgid / NXCD; wgid = (xcd < r ? xcd * (q + 1) : r * (q + 1) + (xcd - r) * q) + off; }
        const int nig = WGM * nN, gid = wgid / nig, fm = gid * WGM, gsz = (nM - fm) < WGM ? (nM - fm) : WGM;
        u.pm = fm + ((wgid % nig) % gsz); u.pn = (wgid % nig) / gsz; return true;
    }
};

struct EpiStore {
    bf16_t* O; int ldc; const float* bias; const float* rs;
    DI void operator()(const f32x4 (&acc)[2][2][4][2], const Unit& u, int wr, int wc, int fr, int fq) const {
        const int row0 = u.pm * BM + wr * 64 + fr; const int col0 = u.pn * BM + wc * 32 + 8 * fq;
        f32x4 bv[2][2];
#pragma unroll
        for (int bj = 0; bj < 2; ++bj)
#pragma unroll
            for (int n = 0; n < 2; ++n) bv[bj][n] = bias ? *(const f32x4*)(bias + col0 + bj * HALF + 4 * n) : (f32x4){0.f, 0.f, 0.f, 0.f};
#pragma unroll
        for (int ai = 0; ai < 2; ++ai)
#pragma unroll
            for (int m = 0; m < 4; ++m) { const int row = row0 + ai * HALF + m * 16; bf16_t* rowp = O + (size_t)row * ldc + col0;
                const float sc = rs ? rs[row] : 1.f;
#pragma unroll
                for (int bj = 0; bj < 2; ++bj) { f32x4 v0 = (acc[ai][bj][m][0] + bv[bj][0]) * sc, v1 = (acc[ai][bj][m][1] + bv[bj][1]) * sc;
                    u32x4 w; w.x = cvt_pk_bf16(v0[0], v0[1]); w.y = cvt_pk_bf16(v0[2], v0[3]); w.z = cvt_pk_bf16(v1[0], v1[1]); w.w = cvt_pk_bf16(v1[2], v1[3]);
                    *(u32x4*)(rowp + bj * HALF) = w; } }
    }
};
DI float silu_mul(float g, float u) { return g * __builtin_amdgcn_rcpf(1.f + __builtin_amdgcn_exp2f(-1.4426950408889634f * g)) * u; }
struct EpiSwiGLU {
    bf16_t* O; const float* rs;
    DI void operator()(const f32x4 (&acc)[2][2][4][2], const Unit& u, int wr, int wc, int fr, int fq) const {
        const int row0 = u.pm * BM + wr * 64 + fr; const int col0 = u.pn * HALF + wc * 32 + 8 * fq;
#pragma unroll
        for (int ai = 0; ai < 2; ++ai)
#pragma unroll
            for (int m = 0; m < 4; ++m) { const int row = row0 + ai * HALF + m * 16; bf16_t* rowp = O + (size_t)row * DFF + col0; const float sc = rs[row];
                const f32x4 g0 = acc[ai][0][m][0] * sc, g1 = acc[ai][0][m][1] * sc, u0 = acc[ai][1][m][0] * sc, u1 = acc[ai][1][m][1] * sc;
                u32x4 w; w.x = cvt_pk_bf16(silu_mul(g0[0], u0[0]), silu_mul(g0[1], u0[1])); w.y = cvt_pk_bf16(silu_mul(g0[2], u0[2]), silu_mul(g0[3], u0[3]));
                w.z = cvt_pk_bf16(silu_mul(g1[0], u1[0]), silu_mul(g1[1], u1[1])); w.w = cvt_pk_bf16(silu_mul(g1[2], u1[2]), silu_mul(g1[3], u1[3]));
                *(u32x4*)rowp = w; }
    }
};
struct EpiQ {
    bf16_t* O; const float* rope;
    DI void operator()(const f32x4 (&acc)[2][2][4][2], const Unit& u, int wr, int wc, int fr, int fq) const {
        const int row0 = u.pm * BM + wr * 64 + fr;
#pragma unroll
        for (int ai = 0; ai < 2; ++ai)
#pragma unroll
            for (int m = 0; m < 4; ++m) { const int row = row0 + ai * HALF + m * 16; const int pos = row < T_HALF ? (row & (S_P - 1)) : (row & (S_S - 1));
#pragma unroll
                for (int bj = 0; bj < 2; ++bj) { const int cb32 = u.pn * BM + bj * HALF + wc * 32, c0 = cb32 + 8 * fq; const int hcb = cb32 % 192;
                    f32x4 v0 = acc[ai][bj][m][0], v1 = acc[ai][bj][m][1];
                    if (hcb >= 128) { const int t = ((hcb - 128) >> 3) + fq; const float* cs = rope + ((size_t)pos * 32 + 4 * t) * 2;
                        const f32x4 a = *(const f32x4*)cs, b = *(const f32x4*)(cs + 4);
                        const f32x4 cv = {a[0], a[2], b[0], b[2]}, sv = {a[1], a[3], b[1], b[3]};
                        const f32x4 o1 = v0 * cv - v1 * sv, o2 = v1 * cv + v0 * sv; v0 = o1; v1 = o2; }
                    u32x4 w; w.x = cvt_pk_bf16(v0[0], v0[1]); w.y = cvt_pk_bf16(v0[2], v0[3]); w.z = cvt_pk_bf16(v1[0], v1[1]); w.w = cvt_pk_bf16(v1[2], v1[3]);
                    *(u32x4*)(O + (size_t)row * 1536 + c0) = w; }
                __builtin_amdgcn_sched_barrier(0); }
    }
};
struct EpiKV {
    bf16_t* Kn; bf16_t* V;
    DI void operator()(const f32x4 (&acc)[2][2][4][2], const Unit& u, int wr, int wc, int fr, int fq) const {
        const int row0 = u.pm * BM + wr * 64 + fr; const int col0 = u.pn * HALF + wc * 32 + 8 * fq;
#pragma unroll
        for (int ai = 0; ai < 2; ++ai)
#pragma unroll
            for (int m = 0; m < 4; ++m) { const size_t off = (size_t)(row0 + ai * HALF + m * 16) * 1024 + col0;
#pragma unroll
                for (int bj = 0; bj < 2; ++bj) { const f32x4 v0 = acc[ai][bj][m][0], v1 = acc[ai][bj][m][1];
                    u32x4 w; w.x = cvt_pk_bf16(v0[0], v0[1]); w.y = cvt_pk_bf16(v0[2], v0[3]); w.z = cvt_pk_bf16(v1[0], v1[1]); w.w = cvt_pk_bf16(v1[2], v1[3]);
                    *(u32x4*)((bj ? V : Kn) + off) = w; } }
    }
};

template <class Epi>
DI void gemm_phase(LAS unsigned char* lds, const Gemm g, const StaticOrder& S, const Epi& E, int wv) {
    const int tid = otid(wv), wid = __builtin_amdgcn_readfirstlane(tid >> 6), lane = tid & 63, wr = wid >> 2, wc = wid & 3, fr = lane & 15, fq = lane >> 4;
    int K = g.K; asm volatile("" : "+s"(K));
    const int nt = K / BK;
    unsigned voffA[2], voffB[2];
#pragma unroll
    for (int i = 0; i < 2; ++i) { int R, C; stage_rc(tid * 16 + i * 8192, R, C); const int Rb = (R & ~31) + perm32(R & 31);
        voffA[i] = (unsigned)(R * g.lda + C) * 2u; voffB[i] = (unsigned)(Rb * K + C) * 2u; }
    const size_t kstep = (size_t)(BK * 2);
    const size_t hA = (size_t)HALF * g.lda * 2, tA = 2 * hA;
    const size_t hB = (size_t)HALF * K * 2, tB = g.b_shared ? 0 : 2 * hB;
    const unsigned ldsw = (unsigned)wid * 1024u;
    const int aoff = lds_byte(wr * 64 + fr, fq * 8), boff = lds_byte(wc * 32 + fr, fq * 8);
#define PG8_SA(b, h) (((b) * 2 + (h)) * HTB)
#define PG8_SB(b, h) ((4 + (b) * 2 + (h)) * HTB)
#define PG8_STAGE(bufoff, gbase, voff) do { _Pragma("unroll") for (int _i = 0; _i < 2; ++_i) \
        __builtin_amdgcn_global_load_lds((const unsigned*)((const char*)(gbase) + (voff)[_i]), (LAS unsigned*)(lds + (bufoff) + ldsw + _i * 8192), 16, 0, 0); } while (0)
#define PG8_LDA(dst, b, h) do { _Pragma("unroll") for (int m = 0; m < 4; ++m) _Pragma("unroll") for (int k = 0; k < 2; ++k) dst[m][k] = *(const LAS bf16x8*)(lds + PG8_SA(b, h) + aoff + m * 2048 + k * 1024); } while (0)
#define PG8_LDB(dst, b, h) do { _Pragma("unroll") for (int n = 0; n < 2; ++n) _Pragma("unroll") for (int k = 0; k < 2; ++k) dst[n][k] = *(const LAS bf16x8*)(lds + PG8_SB(b, h) + boff + n * 2048 + k * 1024); } while (0)
#define PG8_MMA(ai, bj, At, Bt) do { __builtin_amdgcn_s_setprio(1); _Pragma("unroll") for (int m = 0; m < 4; ++m) _Pragma("unroll") for (int n = 0; n < 2; ++n) _Pragma("unroll") for (int k = 0; k < 2; ++k) \
        acc[ai][bj][m][n] = __builtin_amdgcn_mfma_f32_16x16x32_bf16(Bt[n][k], At[m][k], acc[ai][bj][m][n], 0, 0, 0); __builtin_amdgcn_s_setprio(0); } while (0)
#define PG8_WAIT_V(n) asm volatile("s_waitcnt vmcnt(" #n ")" ::: "memory")
#define PG8_WAIT_L(n) asm volatile("s_waitcnt lgkmcnt(" #n ")" ::: "memory")
#define PG8_BAR __builtin_amdgcn_s_barrier()
#define PG8_SCHED __builtin_amdgcn_sched_barrier(0)
    Unit cur, nxt; int ui = 0;
    if (!S.next(0, cur)) return;
    f32x4 acc[2][2][4][2];
#pragma unroll
    for (int a = 0; a < 2; ++a)
#pragma unroll
        for (int b = 0; b < 2; ++b)
#pragma unroll
            for (int m = 0; m < 4; ++m)
#pragma unroll
                for (int n = 0; n < 2; ++n) acc[a][b][m][n] = (f32x4){0.f, 0.f, 0.f, 0.f};
    bf16x8 At[4][2], B0[2][2], B1[2][2];
    const char* cA = (const char*)g.A + (size_t)cur.pm * tA + (size_t)cur.pn * g.a_pn_off; const char* cB = (const char*)g.Bt + (size_t)cur.pn * tB;
    PG8_STAGE(PG8_SB(0, 0), cB, voffB); PG8_STAGE(PG8_SB(0, 1), cB + hB, voffB); PG8_STAGE(PG8_SA(0, 0), cA, voffA); PG8_STAGE(PG8_SA(0, 1), cA + hA, voffA);
    if (wr == 1) PG8_BAR;
    PG8_WAIT_V(2); PG8_BAR;
    PG8_STAGE(PG8_SB(1, 0), cB + kstep, voffB); PG8_STAGE(PG8_SA(1, 0), cA + kstep, voffA); PG8_STAGE(PG8_SB(1, 1), cB + hB + kstep, voffB);
    PG8_WAIT_V(6); PG8_BAR;
    for (;;) {
        const bool has_next = S.next(ui + 1, nxt);
        const char* nA = has_next ? (const char*)g.A + (size_t)nxt.pm * tA + (size_t)nxt.pn * g.a_pn_off : cA; const char* nB = has_next ? (const char*)g.Bt + (size_t)nxt.pn * tB : cB;
        for (int t = 0; t < nt; t += 2) {
            const bool last = (t == nt - 2);
            const size_t sk1 = g.askip ? (size_t)((t + 1) >> 1) * kstep : 0, sk2 = g.askip ? (size_t)((t + 2) >> 1) * kstep : 0, sk3 = g.askip ? (size_t)((t + 3) >> 1) * kstep : 0;
            const char* a1 = cA + (size_t)(t + 1) * kstep + sk1;
            const char* a2 = last ? nA : cA + (size_t)(t + 2) * kstep + sk2; const char* b2 = last ? nB : cB + (size_t)(t + 2) * kstep;
            const char* a3 = last ? nA + kstep : cA + (size_t)(t + 3) * kstep + sk3; const char* b3 = b2 + kstep;
            PG8_LDB(B0, 0, 0); PG8_LDB(B1, 0, 1); PG8_SCHED; PG8_LDA(At, 0, 0); PG8_STAGE(PG8_SA(1, 1), a1 + hA, voffA);
            PG8_WAIT_V(8); PG8_WAIT_L(0); PG8_BAR; PG8_MMA(0, 0, At, B0); PG8_MMA(0, 1, At, B1); PG8_BAR; PG8_SCHED;
            PG8_LDA(At, 0, 1); PG8_STAGE(PG8_SB(0, 0), b2, voffB); PG8_STAGE(PG8_SB(0, 1), b2 + hB, voffB); PG8_STAGE(PG8_SA(0, 0), a2, voffA);
            PG8_WAIT_V(8); PG8_WAIT_L(0); PG8_BAR; PG8_MMA(1, 0, At, B0); PG8_MMA(1, 1, At, B1); PG8_BAR; PG8_SCHED;
            PG8_LDB(B0, 1, 0); PG8_LDB(B1, 1, 1); PG8_SCHED; PG8_LDA(At, 1, 0); PG8_STAGE(PG8_SA(0, 1), a2 + hA, voffA);
            PG8_WAIT_V(8); PG8_WAIT_L(0); PG8_BAR; PG8_MMA(0, 0, At, B0); PG8_MMA(0, 1, At, B1); PG8_BAR; PG8_SCHED;
            PG8_LDA(At, 1, 1); PG8_STAGE(PG8_SB(1, 0), b3, voffB); PG8_STAGE(PG8_SB(1, 1), b3 + hB, voffB); PG8_STAGE(PG8_SA(1, 0), a3, voffA);
            PG8_WAIT_V(8); PG8_WAIT_L(0); PG8_BAR; PG8_MMA(1, 0, At, B0); PG8_MMA(1, 1, At, B1); PG8_BAR; PG8_SCHED;
        }
        if (wr == 0) PG8_BAR;
        { const int l2 = otid(wv) & 63; E(acc, cur, wr, wc, l2 & 15, l2 >> 4); }
        if (!has_next) break;
#pragma unroll
        for (int a = 0; a < 2; ++a)
#pragma unroll
            for (int b = 0; b < 2; ++b)
#pragma unroll
                for (int m = 0; m < 4; ++m)
#pragma unroll
                    for (int n = 0; n < 2; ++n) acc[a][b][m][n] = (f32x4){0.f, 0.f, 0.f, 0.f};
        cur = nxt; cA = nA; cB = nB; ++ui;
        if (wr == 1) PG8_BAR;
    }
    PG8_WAIT_V(0);
    PG8_BAR;
#undef PG8_SA
#undef PG8_SB
#undef PG8_STAGE
#undef PG8_LDA
#undef PG8_LDB
#undef PG8_MMA
#undef PG8_WAIT_V
#undef PG8_WAIT_L
#undef PG8_BAR
#undef PG8_SCHED
}
}

namespace att {
constexpr int NW = 8, QBLK = 32, KVBLK = 64;
constexpr int SHM_V = KVBLK * 128 * 2, SHM_K = KVBLK * 192 * 2;
constexpr int NVS = 3;
constexpr int QR_OFF = NVS * SHM_V + 2 * SHM_K + NW * 64 * 4;
constexpr int LDS_BYTES = QR_OFF + NW * 4096;
constexpr float THR2 = 11.5415603f;
#define KSWZ(row, colB) ((row) * 384 + ((colB) ^ ((((row) >> 1) & 7) << 4)))
#define SBAR() __builtin_amdgcn_sched_barrier(0)
#define LDS_BARRIER() do { SBAR(); asm volatile("s_waitcnt lgkmcnt(0)" ::: "memory"); __builtin_amdgcn_s_barrier(); SBAR(); } while (0)
DI int crow(int r, int hi) { return (r & 3) + 8 * (r >> 2) + 4 * hi; }

DI void partialSM(f32x16& p0, f32x16& p1, float& m_reg, f32x16& negm, float& alpha, bool first) {
    float pmax = p0[0];
#pragma unroll
    for (int r = 1; r < 16; ++r) pmax = fmaxf(pmax, p0[r]);
#pragma unroll
    for (int r = 0; r < 16; ++r) pmax = fmaxf(pmax, p1[r]);
    { auto rr = __builtin_amdgcn_permlane32_swap(__float_as_uint(pmax), __float_as_uint(pmax), false, false);
      pmax = fmaxf(__uint_as_float(rr[0]), __uint_as_float(rr[1])); }
    if (__builtin_expect(!first && __all(pmax <= THR2), 1)) { alpha = 1.f; }
    else { const float delta = first ? pmax : fmaxf(pmax, 0.f); alpha = first ? 0.f : __builtin_amdgcn_exp2f(-delta); m_reg += delta;
#pragma unroll
        for (int r = 0; r < 16; ++r) { p0[r] = p0[r] - delta; p1[r] = p1[r] - delta; negm[r] = -m_reg; } }
#pragma unroll
    for (int r = 0; r < 16; ++r) p0[r] = __builtin_amdgcn_exp2f(p0[r]);
}
DI void finishSM(f32x16& p0, f32x16& p1, float alpha, float& l_reg, bf16x8& pa0, bf16x8& pa1, bf16x8& pa2, bf16x8& pa3) {
#pragma unroll
    for (int r = 0; r < 16; ++r) p1[r] = __builtin_amdgcn_exp2f(p1[r]);
    float ps = 0;
#pragma unroll
    for (int r = 0; r < 16; ++r) ps += p0[r];
#pragma unroll
    for (int r = 0; r < 16; ++r) ps += p1[r];
    { auto rr = __builtin_amdgcn_permlane32_swap(__float_as_uint(ps), __float_as_uint(ps), false, false);
      ps = __uint_as_float(rr[0]) + __uint_as_float(rr[1]); }
    l_reg = l_reg * alpha + ps;
#define PK4(P, BASE, OUT) do { unsigned a0 = cvt_pk_bf16(P[BASE + 0], P[BASE + 1]), a1 = cvt_pk_bf16(P[BASE + 2], P[BASE + 3]);   \
    unsigned b0 = cvt_pk_bf16(P[BASE + 4], P[BASE + 5]), b1 = cvt_pk_bf16(P[BASE + 6], P[BASE + 7]);                              \
    auto r0 = __builtin_amdgcn_permlane32_swap(a0, b0, false, false); auto r1 = __builtin_amdgcn_permlane32_swap(a1, b1, false, false); \
    u32x4 w = {r0[0], r1[0], r0[1], r1[1]}; OUT = *reinterpret_cast<bf16x8*>(&w); } while (0)
    PK4(p0, 0, pa0); PK4(p0, 8, pa1); PK4(p1, 0, pa2); PK4(p1, 8, pa3);
#undef PK4
}
DI void qkt(f32x16& p0, f32x16& p1, const f32x16& negm, const char* Ks, const bf16x8* qr, const char* qrl, const int (&kb)[4]) {
    bf16x8 b0[3], b1[3];
#define KLD(d) do { const char* kp_ = Ks + kb[(d) & 3] + ((d) >> 2) * 128; b0[(d) % 3] = *reinterpret_cast<const bf16x8*>(kp_); b1[(d) % 3] = *reinterpret_cast<const bf16x8*>(kp_ + 32 * 384); } while (0)
    KLD(0); KLD(1);
    __builtin_amdgcn_s_setprio(1);
#pragma unroll
    for (int d0 = 0; d0 < 12; ++d0) {
        if (d0 + 2 < 12) KLD(d0 + 2);
        SBAR();
        const bf16x8 qf = d0 < 8 ? qr[d0 < 8 ? d0 : 0] : *reinterpret_cast<const bf16x8*>(qrl + (d0 - 8) * 1024);
        p0 = __builtin_amdgcn_mfma_f32_32x32x16_bf16(b0[d0 % 3], qf, d0 == 0 ? negm : p0, 0, 0, 0);
        p1 = __builtin_amdgcn_mfma_f32_32x32x16_bf16(b1[d0 % 3], qf, d0 == 0 ? negm : p1, 0, 0, 0);
        SBAR(); }
    __builtin_amdgcn_s_setprio(0);
#undef KLD
}
DI int v_st(int k, int c) { const int kk = (k & ~0xC) | ((k & 4) << 1) | ((k & 8) >> 1); return ((kk >> 3) * 4 + (c >> 5)) * 512 + ((kk & 7) * 32 + (c & 31)) * 2; }
DI int v_rd_base(int lane) { return ((lane & 3) << 3) | (((lane >> 2) & 3) << 6) | (((lane >> 4) & 1) << 5) | (((lane >> 5) & 1) << 8); }
constexpr int v_rd_off(int d0, int ks, int half) { return d0 * 512 + ks * 4096 + half * 2048; }
template <int OFF> DI s16x4 tr_read(int vb) {
    s16x4 r; asm volatile("ds_read_b64_tr_b16 %0, %1 offset:%2" : "=&v"(r) : "v"(vb), "i"(OFF) : "memory"); return r;
}
#define PV_READS(D0, L0, H0, L1, H1, L2, H2, L3, H3) do { L0 = tr_read<v_rd_off(D0, 0, 0)>(vb); H0 = tr_read<v_rd_off(D0, 0, 1)>(vb); L1 = tr_read<v_rd_off(D0, 1, 0)>(vb); H1 = tr_read<v_rd_off(D0, 1, 1)>(vb); \
    L2 = tr_read<v_rd_off(D0, 2, 0)>(vb); H2 = tr_read<v_rd_off(D0, 2, 1)>(vb); L3 = tr_read<v_rd_off(D0, 3, 0)>(vb); H3 = tr_read<v_rd_off(D0, 3, 1)>(vb); } while (0)
#define PK(L, H) (bf16x8){L[0], L[1], L[2], L[3], H[0], H[1], H[2], H[3]}
#define PV_MMA(od, L0, H0, L1, H1, L2, H2, L3, H3) do { od = __builtin_amdgcn_mfma_f32_32x32x16_bf16(pa0, PK(L0, H0), od, 0, 0, 0); od = __builtin_amdgcn_mfma_f32_32x32x16_bf16(pa1, PK(L1, H1), od, 0, 0, 0); \
    od = __builtin_amdgcn_mfma_f32_32x32x16_bf16(pa2, PK(L2, H2), od, 0, 0, 0); od = __builtin_amdgcn_mfma_f32_32x32x16_bf16(pa3, PK(L3, H3), od, 0, 0, 0); } while (0)
DI void pv_d0(f32x16* o, int vb, bf16x8 pa0, bf16x8 pa1, bf16x8 pa2, bf16x8 pa3) {
    s16x4 a0, a1, a2, a3, a4, a5, a6, a7, b0, b1, b2, b3, b4, b5, b6, b7;
    PV_READS(0, a0, a1, a2, a3, a4, a5, a6, a7);
    PV_READS(1, b0, b1, b2, b3, b4, b5, b6, b7);
    asm volatile("s_waitcnt lgkmcnt(8)" ::: "memory"); SBAR();
    PV_MMA(o[0], a0, a1, a2, a3, a4, a5, a6, a7); SBAR();
    PV_READS(2, a0, a1, a2, a3, a4, a5, a6, a7);
    asm volatile("s_waitcnt lgkmcnt(8)" ::: "memory"); SBAR();
    PV_MMA(o[1], b0, b1, b2, b3, b4, b5, b6, b7); SBAR();
    PV_READS(3, b0, b1, b2, b3, b4, b5, b6, b7);
    asm volatile("s_waitcnt lgkmcnt(8)" ::: "memory"); SBAR();
    PV_MMA(o[2], a0, a1, a2, a3, a4, a5, a6, a7); SBAR();
    asm volatile("s_waitcnt lgkmcnt(0)" ::: "memory"); SBAR();
    PV_MMA(o[3], b0, b1, b2, b3, b4, b5, b6, b7);
}
#undef PV_READS
#undef PV_MMA
#undef PK

DI void attn_unit(const bf16_t* __restrict__ Qb, const bf16_t* __restrict__ Kn, const bf16_t* __restrict__ Kr, const bf16_t* __restrict__ Vh,
                  bf16_t* Ob, int seq, char* lds, int wv, const float* __restrict__ rope, int pos0) {
    const int tid = otid(wv), wid = tid >> 6, lane = tid & 63, r32 = lane & 31, hi = lane >> 5;
    char* V_lds = lds; char* K_lds = lds + NVS * SHM_V;
    float* ws = (float*)(lds + NVS * SHM_V + 2 * SHM_K) + wid * 64; float* li_l = ws; float* al_l = ws + 32;
    float m_reg = 0.f, l_reg = 0; f32x16 o[4]; bf16x8 qr[8]; f32x16 negm;
#pragma unroll
    for (int r = 0; r < 16; ++r) negm[r] = 0.f;
    char* qrl = lds + QR_OFF + wid * 4096 + lane * 16;
#pragma unroll
    for (int d = 0; d < 4; ++d)
#pragma unroll
        for (int r = 0; r < 16; ++r) o[d][r] = 0.f;
    const bf16_t* Qw = Qb + (size_t)(wid * QBLK + r32) * 1536 + hi * 8;
#pragma unroll
    for (int d0 = 0; d0 < 8; ++d0) qr[d0] = gld_bf8(Qw + d0 * 16);
#pragma unroll
    for (int d0 = 8; d0 < 12; ++d0) {
        const u32x4 raw = gld_u4(Qw + d0 * 16);
        const float* cs = rope + ((size_t)(pos0 + wid * QBLK + r32) * 32 + 4 * (2 * (d0 - 8) + hi)) * 2;
        const f32x4 ca = gld_f4(cs), cb = gld_f4(cs + 4);
        const float x10 = bf2f(raw.x & 0xffff), x11 = bf2f(raw.x >> 16), x12 = bf2f(raw.y & 0xffff), x13 = bf2f(raw.y >> 16);
        const float x20 = bf2f(raw.z & 0xffff), x21 = bf2f(raw.z >> 16), x22 = bf2f(raw.w & 0xffff), x23 = bf2f(raw.w >> 16);
        u32x4 w;
        w.x = cvt_pk_bf16(x10 * ca[0] - x20 * ca[1], x11 * ca[2] - x21 * ca[3]); w.y = cvt_pk_bf16(x12 * cb[0] - x22 * cb[1], x13 * cb[2] - x23 * cb[3]);
        w.z = cvt_pk_bf16(x20 * ca[0] + x10 * ca[1], x21 * ca[2] + x11 * ca[3]); w.w = cvt_pk_bf16(x22 * cb[0] + x12 * cb[1], x23 * cb[2] + x13 * cb[3]);
        *reinterpret_cast<u32x4*>(qrl + (d0 - 8) * 1024) = w; }
    const int sr = tid >> 4, sc = (tid & 15) * 8, vst0 = v_st(sr, sc), vst1 = v_st(32 + sr, sc);
    const int kr_ = tid >> 3, kc = (tid & 7) * 8;
    const int kst0 = KSWZ(kr_, kc * 2), kst1 = KSWZ(kr_, (64 + kc) * 2), kst2 = KSWZ(kr_, (128 + kc) * 2);
    const int vb0 = (int)(uintptr_t)V_lds + v_rd_base(lane);
    int kb[4];
#pragma unroll
    for (int i = 0; i < 4; ++i) kb[i] = KSWZ(r32, (i * 16 + hi * 8) * 2);
    bf16x8 vs0, vs1, ks0, ks1, ks2;
    const unsigned offV0 = (unsigned)(sr * 1024 + sc) * 2u, offK0 = (unsigned)(kr_ * 1024 + kc) * 2u, offR = (unsigned)(kr_ * 64 + kc) * 2u;
#define SLOAD(k0) do { const char* vt_ = (const char*)(Vh + (size_t)(k0) * 1024); const char* kt_ = (const char*)(Kn + (size_t)(k0) * 1024); const char* rt_ = (const char*)(Kr + (size_t)(k0) * 64); \
    vs0 = gld_bf8(vt_ + offV0); vs1 = gld_bf8(vt_ + offV0 + 65536u); \
    ks0 = gld_bf8(kt_ + offK0); ks1 = gld_bf8(kt_ + offK0 + 128u); \
    ks2 = gld_bf8(rt_ + offR); } while (0)
#define SWRITE(vo, ko) do { *(bf16x8*)(V_lds + (vo) + vst0) = vs0; *(bf16x8*)(V_lds + (vo) + vst1) = vs1; \
    *(bf16x8*)(K_lds + (ko) + kst0) = ks0; *(bf16x8*)(K_lds + (ko) + kst1) = ks1; *(bf16x8*)(K_lds + (ko) + kst2) = ks2; } while (0)
#define SWAIT() asm volatile("s_waitcnt vmcnt(0)" ::: "memory")
#define RESC(a) do { if (__any((a) < 1.f)) { if (hi == 0) al_l[r32] = (a); asm volatile("s_waitcnt lgkmcnt(0)" ::: "memory"); \
    _Pragma("unroll") for (int d = 0; d < 4; ++d) _Pragma("unroll") for (int r = 0; r < 16; ++r) o[d][r] *= al_l[crow(r, hi)]; } } while (0)
    f32x16 pA0, pA1; float alA; bf16x8 pa0, pa1, pa2, pa3; const int NT = seq / KVBLK;
    const bool grpB = (wv >= 4);
    int vcur = 0, kcur = 0;
    int vnxt = SHM_V, knxt = SHM_K;
#define STAGE_NEXT(jn) do { SWAIT(); SWRITE(vnxt, knxt); SBAR(); if ((jn) + 1 < NT) SLOAD(((jn) + 1) * KVBLK); SBAR(); asm volatile("s_waitcnt lgkmcnt(0)" ::: "memory"); __builtin_amdgcn_s_barrier(); SBAR(); } while (0)
    SLOAD(0); SWAIT(); SWRITE(0, 0); SBAR(); SLOAD(KVBLK); LDS_BARRIER();
    for (int j = 0; j < NT; ++j) {
        qkt(pA0, pA1, negm, K_lds + kcur, qr, qrl, kb); partialSM(pA0, pA1, m_reg, negm, alA, j == 0);
        RESC(alA);
        finishSM(pA0, pA1, alA, l_reg, pa0, pa1, pa2, pa3); SBAR();
        if (grpB && j + 1 < NT) STAGE_NEXT(j + 1);
        pv_d0(o, vb0 + vcur, pa0, pa1, pa2, pa3);
        SBAR();
        if (!grpB && j + 1 < NT) STAGE_NEXT(j + 1);
        vcur = vnxt; kcur = knxt; vnxt = (vnxt == (NVS - 1) * SHM_V) ? 0 : vnxt + SHM_V; knxt ^= SHM_K;
    }
#undef STAGE_NEXT
    if (hi == 0) li_l[r32] = l_reg; asm volatile("s_waitcnt lgkmcnt(0)" ::: "memory");
    bf16_t* Ow = Ob + (size_t)(wid * QBLK + 4 * hi) * 1536 + r32;
    asm volatile("" : "+v"(Ow));
#pragma unroll
    for (int r = 0; r < 16; ++r) { const int orow = crow(r, hi); const float rl = __builtin_amdgcn_rcpf(li_l[orow]);
        bf16_t* Or = Ow + ((r & 3) + 8 * (r >> 2)) * 1536;
#pragma unroll
        for (int d0 = 0; d0 < 4; ++d0) gst_h(Or + d0 * 32, f2bf(o[d0][r] * rl)); }
    LDS_BARRIER();
#undef SLOAD
#undef SWRITE
#undef SWAIT
#undef RESC
}
}

namespace fft {
DI s16x4 trr(unsigned addr) { s16x4 r; asm volatile("ds_read_b64_tr_b16 %0, %1" : "=&v"(r) : "v"(addr) : "memory"); return r; }
DI int crow(int r, int hi) { return (r & 3) + 8 * (r >> 2) + 4 * hi; }

template <int NN, int STAGE>
DI void fft_phase(char* lds, const bf16_t* __restrict__ src, bf16_t* __restrict__ dst, int nbatch, int G, int bid, int wv) {
    constexpr int S = NN * NN;
    constexpr int CW = (STAGE == 1) ? 256 : 128;
    constexpr int NCC = 1024 / CW;
    constexpr int KR = (STAGE == 1) ? NN : 2 * NN;
    constexpr int RS = CW * 2 + 64;
    constexpr int KS = KR / 16;
    constexpr int NROWT = NN / 16;
    constexpr int NCPART = 8 / NROWT;
    constexpr int NCBW = (CW / 32) / NCPART;
    constexpr int C16 = CW / 8;
    constexpr int NLD = KR * C16 / 512;
    const int tid = otid(wv), wid = tid >> 6, lane = tid & 63, m32 = lane & 31, h = lane >> 5;
    const int rt = wid % NROWT, cpart = wid / NROWT;
    const int nunits = nbatch * NN * NCC;
    bf16x8 areg[KS];
#pragma unroll
    for (int s = 0; s < KS; ++s) {
        float v[8];
#pragma unroll
        for (int j = 0; j < 8; ++j) { const int k = 16 * s + 8 * h + j;
            if (STAGE == 1) { const int c = 16 * rt + (m32 & 15), reim = m32 >> 4; const float fr = (float)((k * c) & (NN - 1)) * (1.0f / NN);
                v[j] = reim ? -sin2pi(fr) : cos2pi(fr); }
            else { const int R = 32 * rt + m32, ro = R / NN, d = R % NN, ri = k / NN, b = k % NN; const float fr = (float)((b * d) & (NN - 1)) * (1.0f / NN);
                const float cs = cos2pi(fr), sn = sin2pi(fr); v[j] = (ro == 0) ? (ri == 0 ? cs : sn) : (ri == 0 ? -sn : cs); } }
        u32x4 w = {cvt_pk_bf16(v[0], v[1]), cvt_pk_bf16(v[2], v[3]), cvt_pk_bf16(v[4], v[5]), cvt_pk_bf16(v[6], v[7])};
        areg[s] = *reinterpret_cast<bf16x8*>(&w);
    }
    const unsigned ldsb = (unsigned)(uintptr_t)lds;
    const int i16 = lane & 15, q = i16 >> 2, p = i16 & 3, blk = (lane >> 4) & 1;
    const unsigned rbase = ldsb + (unsigned)((8 * h + q) * RS + (16 * blk + 4 * p) * 2);
    u32x4 pre[NLD];
    auto unit_src = [&](int u, int& bt, int& x, int& cc) -> const bf16_t* {
        cc = u % NCC; const int t = u / NCC; x = t % NN; bt = t / NN;
        if (STAGE == 1) return src + ((size_t)bt * S + x) * 1024 + cc * CW;
        else return src + ((size_t)(bt * NN + x) * 2 * NN) * 1024 + cc * CW;
    };
    constexpr size_t ROWSTEP = (STAGE == 1) ? (size_t)NN * 1024 : 1024;
    int u = bid;
    if (u < nunits) { int bt, x, cc; const bf16_t* sp = unit_src(u, bt, x, cc);
#pragma unroll
        for (int i = 0; i < NLD; ++i) { const int ch = tid + i * 512, row = ch / C16, c16 = ch % C16; pre[i] = gld_u4(sp + (size_t)row * ROWSTEP + c16 * 8); } }
    for (; u < nunits; u += G) {
        int bt, x, cc; (void)unit_src(u, bt, x, cc);
        LDS_BARRIER();
#pragma unroll
        for (int i = 0; i < NLD; ++i) { const int ch = tid + i * 512, row = ch / C16, c16 = ch % C16; *(u32x4*)(lds + row * RS + c16 * 16) = pre[i]; }
        LDS_BARRIER();
        if (u + G < nunits) { int bt2, x2, cc2; const bf16_t* sp = unit_src(u + G, bt2, x2, cc2);
#pragma unroll
            for (int i = 0; i < NLD; ++i) { const int ch = tid + i * 512, row = ch / C16, c16 = ch % C16; pre[i] = gld_u4(sp + (size_t)row * ROWSTEP + c16 * 8); } }
        float tc[8], tsn[8];
        if (STAGE == 1) {
#pragma unroll
            for (int r = 0; r < 8; ++r) { const int c = 16 * rt + crow(r, h); const float fr = (float)((x * c) & (S - 1)) * (1.0f / S); tc[r] = cos2pi(fr); tsn[r] = sin2pi(fr); }
        }
#pragma unroll 1
        for (int cbi = 0; cbi < NCBW; ++cbi) {
            const int cb = cpart * NCBW + cbi;
            f32x16 acc;
#pragma unroll
            for (int r = 0; r < 16; ++r) acc[r] = 0.f;
            const unsigned cbase = rbase + (unsigned)(cb * 64);
#pragma unroll
            for (int s0 = 0; s0 < KS; s0 += 4) {
                s16x4 lo[4], hh[4];
#pragma unroll
                for (int i = 0; i < 4; ++i) { lo[i] = trr(cbase + (unsigned)((s0 + i) * 16 * RS)); hh[i] = trr(cbase + (unsigned)((s0 + i) * 16 * RS + 4 * RS)); }
                asm volatile("s_waitcnt lgkmcnt(0)" ::: "memory"); __builtin_amdgcn_sched_barrier(0);
#pragma unroll
                for (int i = 0; i < 4; ++i) { const bf16x8 bfr = (bf16x8){lo[i][0], lo[i][1], lo[i][2], lo[i][3], hh[i][0], hh[i][1], hh[i][2], hh[i][3]};
                    acc = __builtin_amdgcn_mfma_f32_32x32x16_bf16(areg[s0 + i], bfr, acc, 0, 0, 0); }
            }
            const int col = cc * CW + cb * 32 + m32;
            if (STAGE == 1) {
#pragma unroll
                for (int r = 0; r < 8; ++r) { const int c = 16 * rt + crow(r, h); const float tr_ = acc[r], ti = acc[r + 8];
                    const float o_r = tr_ * tc[r] + ti * tsn[r], o_i = ti * tc[r] - tr_ * tsn[r];
                    bf16_t* dp = dst + (((size_t)(bt * NN + c) * 2) * NN + x) * 1024 + col;
                    gst_h(dp, f2bf(o_r)); gst_h(dp + (size_t)NN * 1024, f2bf(o_i)); }
            } else {
#pragma unroll
                for (int r = 0; r < 16; ++r) { const int R = 32 * rt + crow(r, h), ro = R / NN, d = R % NN;
                    const size_t tok = (size_t)bt * S + x + (size_t)NN * d;
                    gst_h(dst + tok * 2048 + (col >> 8) * 512 + ro * 256 + (col & 255), f2bf(acc[r])); }
            }
        }
    }
    __syncthreads();
}
}

struct Args {
    const float* xp; const float* xs; const float* norm_g; const float* fnet_w; const float* fnet_b; const float* w_down; const float* q_norm; const float* w_uq;
    const float* kv_norm; const float* w_ukv; const float* w_o; const float* w_gate; const float* w_up; const float* w_fdown;
    float* out; unsigned char* ws; int ph_lo, ph_hi;
};

enum { JOB_FN = 0, JOB_DFT, JOB_DN, JOB_UQ, JOB_UKV, JOB_WO, JOB_GU, JOB_FD };
DI float prep_val(const Args& a, int job, int layer, int k, int n) {
    switch (job) {
    case JOB_FN: return a.fnet_w[(size_t)k * 1024 + n];
    case JOB_DFT: { const int ri = k >> 8, n2 = k & 255; const float fr = (float)((n2 * n) & 255) * (1.0f / 256); return ri ? sin2pi(fr) : cos2pi(fr); }
    case JOB_DN: return n < 576 ? a.norm_g[(4 + 0) * 1024 + k] * a.w_down[(size_t)k * 576 + n] : 0.f;
    case JOB_UQ: { const int hh = n / 192, c = n % 192; int sc = c; if (c >= 128) { const int p = c - 128; sc = 128 + 32 * ((p >> 2) & 1) + 4 * (p >> 3) + (p & 3); }
        return a.q_norm[k] * a.w_uq[(size_t)k * 1536 + hh * 192 + sc] * QSCALE; }
    case JOB_UKV: return a.kv_norm[k] * a.w_ukv[(size_t)k * 2048 + n];
    case JOB_WO: return a.w_o[(size_t)k * 1024 + n];
    case JOB_GU: { const int pn = n >> 8, isup = (n >> 7) & 1, col = pn * 128 + (n & 127); const float* w = (isup ? a.w_up : a.w_gate) + (size_t)layer * 1024 * DFF;
        return a.norm_g[(layer * 4 + 2) * 1024 + k] * w[(size_t)k * DFF + col]; }
    default: return a.w_fdown[(size_t)layer * DFF * 1024 + (size_t)k * 1024 + n];
    }
}
DI void prep_job(const Args& a, int job, int layer, int N, int K, bf16_t* dst, float* scr, int item0, int& item_base, int G, int bid, int wv) {
    const int tn = N / 64, tk = K / 64, n_items = tn * tk, tid = otid(wv);
    int first = item_base; item_base += n_items;
    int i = bid - (first % G); if (i < 0) i += G;
    for (; i < n_items; i += G) {
        const int n0 = (i % tn) * 64, k0 = (i / tn) * 64;
        __syncthreads();
#pragma unroll
        for (int e8 = 0; e8 < 8; ++e8) { const int e = tid + e8 * 512, kk = e >> 6, nn = e & 63; scr[nn * 65 + kk] = prep_val(a, job, layer, k0 + kk, n0 + nn); }
        __syncthreads();
#pragma unroll
        for (int e4 = 0; e4 < 4; ++e4) { const int e = tid + e4 * 512, nn = e >> 5, k2 = (e & 31) * 2;
            *(unsigned*)(dst + (size_t)(n0 + nn) * K + k0 + k2) = cvt_pk_bf16(scr[nn * 65 + k2], scr[nn * 65 + k2 + 1]); }
    }
    (void)item0;
}

DI void row_first(const Args& a, bf16_t* H, int G, int bid, int wv) {
    const int tid_ = otid(wv), wid = tid_ >> 6, lane = tid_ & 63;
    const float* g = a.norm_g;
    for (int row = bid * 8 + wid; row < T_ALL; row += G * 8) {
        const float* xr = row < T_HALF ? a.xp + (size_t)row * 1024 : a.xs + (size_t)(row - T_HALF) * 1024;
        f32x4 x[4]; float ss = 0.f;
#pragma unroll
        for (int hv = 0; hv < 2; ++hv) { x[2 * hv] = *(const f32x4*)(xr + hv * 512 + lane * 8); x[2 * hv + 1] = *(const f32x4*)(xr + hv * 512 + lane * 8 + 4); }
#pragma unroll
        for (int i = 0; i < 4; ++i)
#pragma unroll
            for (int j = 0; j < 4; ++j) ss += x[i][j] * x[i][j];
        ss = wave_sum(ss); const float r = rsqrtf(ss * (1.0f / 1024) + NORM_EPS);
#pragma unroll
        for (int hv = 0; hv < 2; ++hv) { const int c = hv * 512 + lane * 8; const f32x4 g0 = *(const f32x4*)(g + c), g1 = *(const f32x4*)(g + c + 4);
            const f32x4 y0 = x[2 * hv] * r * g0, y1 = x[2 * hv + 1] * r * g1;
            u32x4 w = {cvt_pk_bf16(y0[0], y0[1]), cvt_pk_bf16(y0[2], y0[3]), cvt_pk_bf16(y1[0], y1[1]), cvt_pk_bf16(y1[2], y1[3])};
            *(u32x4*)(H + (size_t)row * 1024 + c) = w; }
    }
}
DI void row_mid(const bf16_t* m, const float* gpost, const float* xf0, const float* xf1, const bf16_t* xb_in, bf16_t* xb_out, float* rs_out, float* out_f, int G, int bid, int wv) {
    const int tid_ = otid(wv), wid = tid_ >> 6, lane = tid_ & 63;
    constexpr int NR = 2;
    const int rstep = G * 8, step = rstep * NR;
#define RM_LOAD(X, MW, R0) do { _Pragma("unroll") for (int q = 0; q < NR; ++q) { const int row = min((R0) + q * rstep, T_ALL - 1); \
        _Pragma("unroll") for (int hv = 0; hv < 2; ++hv) { const int c = hv * 512 + lane * 8; \
            if (xb_in) { const u32x4 w = gld_u4(xb_in + (size_t)row * 1024 + c); \
                X[q][2 * hv] = (f32x4){bf2f(w.x & 0xffff), bf2f(w.x >> 16), bf2f(w.y & 0xffff), bf2f(w.y >> 16)}; \
                X[q][2 * hv + 1] = (f32x4){bf2f(w.z & 0xffff), bf2f(w.z >> 16), bf2f(w.w & 0xffff), bf2f(w.w >> 16)}; } \
            else { const float* xr = row < T_HALF ? xf0 + (size_t)row * 1024 : xf1 + (size_t)(row - T_HALF) * 1024; \
                X[q][2 * hv] = gld_f4(xr + c); X[q][2 * hv + 1] = gld_f4(xr + c + 4); } \
            MW[q][hv] = gld_u4(m + (size_t)row * 1024 + c); } } } while (0)
#define RM_PROC(X, MW, R0) do { _Pragma("unroll") for (int q = 0; q < NR; ++q) { const int row = (R0) + q * rstep; if (row >= T_ALL) continue; \
        f32x4 mv[4]; float ss = 0.f; \
        _Pragma("unroll") for (int hv = 0; hv < 2; ++hv) { const u32x4 w = MW[q][hv]; \
            mv[2 * hv] = (f32x4){bf2f(w.x & 0xffff), bf2f(w.x >> 16), bf2f(w.y & 0xffff), bf2f(w.y >> 16)}; \
            mv[2 * hv + 1] = (f32x4){bf2f(w.z & 0xffff), bf2f(w.z >> 16), bf2f(w.w & 0xffff), bf2f(w.w >> 16)}; } \
        _Pragma("unroll") for (int i = 0; i < 4; ++i) _Pragma("unroll") for (int j = 0; j < 4; ++j) ss += mv[i][j] * mv[i][j]; \
        ss = wave_sum(ss); const float r1 = rsqrtf(ss * (1.0f / 1024) + NORM_EPS); \
        float s2 = 0.f; \
        _Pragma("unroll") for (int hv = 0; hv < 2; ++hv) { const int c = hv * 512 + lane * 8; const f32x4 g0 = gld_f4(gpost + c), g1 = gld_f4(gpost + c + 4); \
            X[q][2 * hv] = X[q][2 * hv] + mv[2 * hv] * r1 * g0; X[q][2 * hv + 1] = X[q][2 * hv + 1] + mv[2 * hv + 1] * r1 * g1; \
            if (out_f) { gst_f4(out_f + (size_t)row * 1024 + c, X[q][2 * hv]); gst_f4(out_f + (size_t)row * 1024 + c + 4, X[q][2 * hv + 1]); } \
            else { const f32x4 y0 = X[q][2 * hv], y1 = X[q][2 * hv + 1]; \
                u32x4 w = {cvt_pk_bf16(y0[0], y0[1]), cvt_pk_bf16(y0[2], y0[3]), cvt_pk_bf16(y1[0], y1[1]), cvt_pk_bf16(y1[2], y1[3])}; \
                gst_u4(xb_out + (size_t)row * 1024 + c, w); } } \
        if (rs_out) { \
            _Pragma("unroll") for (int i = 0; i < 4; ++i) _Pragma("unroll") for (int j = 0; j < 4; ++j) s2 += X[q][i][j] * X[q][i][j]; \
            s2 = wave_sum(s2); if (lane == 0) rs_out[row] = rsqrtf(s2 * (1.0f / 1024) + NORM_EPS); } } } while (0)
    f32x4 xa[NR][4], xb2[NR][4]; u32x4 ma[NR][2], mb[NR][2];
    int row0 = bid * 8 + wid;
    if (row0 < T_ALL) RM_LOAD(xa, ma, row0);
    while (row0 < T_ALL) {
        const int rowB = row0 + step; const bool hb = rowB < T_ALL;
        if (hb) RM_LOAD(xb2, mb, rowB);
        RM_PROC(xa, ma, row0);
        if (!hb) break;
        const int rowA = rowB + step; const bool ha = rowA < T_ALL;
        if (ha) RM_LOAD(xa, ma, rowA);
        RM_PROC(xb2, mb, rowB);
        if (!ha) break;
        row0 = rowA;
    }
#undef RM_LOAD
#undef RM_PROC
}
DI void row_mla(const bf16_t* down, const float* rope, bf16_t* cq, bf16_t* ckv, bf16_t* kr, int G, int bid, int wv) {
    const int tid_ = otid(wv), wid = tid_ >> 6, lane = tid_ & 63;
    for (int row = bid * 8 + wid; row < T_ALL; row += G * 8) {
        const bf16_t* dr = down + (size_t)row * 768;
        const u32x2 a = *(const u32x2*)(dr + lane * 4), b = *(const u32x2*)(dr + 256 + lane * 4);
        const float a0 = bf2f(a.x & 0xffff), a1 = bf2f(a.x >> 16), a2 = bf2f(a.y & 0xffff), a3 = bf2f(a.y >> 16);
        const float b0 = bf2f(b.x & 0xffff), b1 = bf2f(b.x >> 16), b2 = bf2f(b.y & 0xffff), b3 = bf2f(b.y >> 16);
        const float sa = wave_sum(a0 * a0 + a1 * a1 + a2 * a2 + a3 * a3), sb = wave_sum(b0 * b0 + b1 * b1 + b2 * b2 + b3 * b3);
        const float ra = rsqrtf(sa * (1.0f / 256) + NORM_EPS), rb = rsqrtf(sb * (1.0f / 256) + NORM_EPS);
        u32x2 wa = {cvt_pk_bf16(a0 * ra, a1 * ra), cvt_pk_bf16(a2 * ra, a3 * ra)}, wb = {cvt_pk_bf16(b0 * rb, b1 * rb), cvt_pk_bf16(b2 * rb, b3 * rb)};
        *(u32x2*)(cq + (size_t)row * 256 + lane * 4) = wa; *(u32x2*)(ckv + (size_t)row * 256 + lane * 4) = wb;
        const float xv = bf2f(dr[512 + lane]); const float xo = __shfl_xor(xv, 32);
        const int pos = row < T_HALF ? (row & (S_P - 1)) : (row & (S_S - 1)); const int i = lane & 31;
        const float cs = rope[((size_t)pos * 32 + i) * 2], sn = rope[((size_t)pos * 32 + i) * 2 + 1];
        const float ov = lane < 32 ? (xv * cs - xo * sn) : (xv * cs + xo * sn);
        const int pidx = 8 * (i >> 2) + 4 * (lane >> 5) + (i & 3);
        kr[(size_t)row * 64 + pidx] = f2bf(ov);
    }
}


#define XB_TMO      128
#define XB_XCNT(j)  (256  + 64 * (j))
#define XB_XSUB(j)  (1280 + 64 * (j))
#define XB_XGEN(j)  (2304 + 64 * (j))
#define XB_TOP      3328
#define XB_TOPGEN   3392
#define XB_SPIN_CAP (1u << 22)
DI unsigned xb_ld(unsigned* p)              { return __hip_atomic_load(p, __ATOMIC_RELAXED, __HIP_MEMORY_SCOPE_AGENT); }
DI unsigned xb_add(unsigned* p, unsigned v) { return __hip_atomic_fetch_add(p, v, __ATOMIC_RELAXED, __HIP_MEMORY_SCOPE_AGENT); }
DI unsigned xb_xcc_id() { return (unsigned)__builtin_amdgcn_s_getreg((3 << 11) | 20) & 0xFu; }
#define XB_SPIN(cond, bar) do { unsigned _sp = 0; while (cond) { __builtin_amdgcn_s_sleep(1); \
    if ((++_sp & 255u) == 0u) { if (xb_ld(&(bar)[XB_TMO])) break; if (_sp > XB_SPIN_CAP) { atomicAdd(&(bar)[XB_TMO], 1u); break; } } } } while (0)
struct XcdBarrier { unsigned* bar; unsigned x; volatile LAS unsigned* st; };
DI void xcd_barrier_complete(unsigned* bar, unsigned x, unsigned& nloc, unsigned& nx) {
    const unsigned G = gridDim.x;
    unsigned sum, cnt, mine, sp = 0u;
    for (;;) {
        sum = 0u; cnt = 0u; mine = 0u;
#pragma unroll
        for (unsigned j = 0; j < 16; ++j) { const unsigned c = xb_ld(&bar[XB_XCNT(j)]); sum += c; cnt += (c > 0u) ? 1u : 0u; mine = (j == x) ? c : mine; }
        if (sum == G) break;
        __builtin_amdgcn_s_sleep(1);
        if ((++sp & 255u) == 0u) { if (xb_ld(&bar[XB_TMO])) break; if (sp > XB_SPIN_CAP) { atomicAdd(&bar[XB_TMO], 1u); break; } }
    }
    nloc = mine > 0u ? mine : 1u; nx = cnt > 0u ? cnt : 1u;
}
DI void xcd_barrier(const XcdBarrier& b, int wv) {
    asm volatile("s_waitcnt vmcnt(0)" ::: "memory");
    __syncthreads();
    if (otid(wv) == 0) {
        unsigned* bar = b.bar;
        __builtin_amdgcn_s_waitcnt(0);
        unsigned nloc = b.st[0], nx = b.st[1];
        if (nloc == 0u) { xcd_barrier_complete(bar, b.x, nloc, nx); b.st[0] = nloc; b.st[1] = nx; }
        const unsigned old = xb_add(&bar[XB_XSUB(b.x)], 1u);
        const unsigned gen = old / nloc;
        if (old + 1u == (gen + 1u) * nloc) {
            __builtin_amdgcn_fence(__ATOMIC_RELEASE, "agent");
            asm volatile("s_waitcnt vmcnt(0)" ::: "memory");
            const unsigned og = xb_add(&bar[XB_TOP], 1u);
            const unsigned tg = og / nx;
            if (og + 1u == (tg + 1u) * nx) xb_add(&bar[XB_TOPGEN], 1u);
            else XB_SPIN(xb_ld(&bar[XB_TOPGEN]) == tg, bar);
            __builtin_amdgcn_fence(__ATOMIC_ACQUIRE, "agent");
            xb_add(&bar[XB_XGEN(b.x)], 1u);
            asm volatile("s_waitcnt vmcnt(0)" ::: "memory");
        } else {
            XB_SPIN(xb_ld(&bar[XB_XGEN(b.x)]) == gen, bar);
            __builtin_amdgcn_fence(__ATOMIC_ACQUIRE, "agent");
            asm volatile("s_waitcnt vmcnt(0)" ::: "memory");
        }
    }
    __syncthreads();
}

constexpr int LDS_BYTES = 147456;
constexpr int LDS_BAR_OFF = LDS_BYTES - 64;
constexpr int NPHASE = 27;

DI unsigned char* opq(unsigned char* p) { asm volatile("" : "+s"(p)); return (unsigned char*)(__attribute__((address_space(1))) unsigned char*)p; }
__global__ void __launch_bounds__(512, 2) mega(Args a) {
    extern __shared__ __attribute__((aligned(16))) unsigned char lds[];
    cg::grid_group grid = cg::this_grid();
    const int G = gridDim.x, bid = blockIdx.x, wv = __builtin_amdgcn_readfirstlane((int)threadIdx.x >> 6);
    const int lo = a.ph_lo, hi = a.ph_hi;
#ifndef PHMASK
#define PHMASK 0xFFFFFFFFu
#endif
#define IN(k) ((((PHMASK) >> (k)) & 1u) && lo <= (k) && (k) < hi)
    XcdBarrier xbar; xbar.bar = (unsigned*)a.ws; xbar.x = xb_xcc_id(); xbar.st = (volatile LAS unsigned*)((LAS unsigned char*)lds + LDS_BAR_OFF);
    if (threadIdx.x < 2) xbar.st[threadIdx.x] = 0u;
    if (threadIdx.x == 0) (void)xb_add(&xbar.bar[XB_XCNT(xbar.x)], 1u);
    __syncthreads();
    if (lo < 0) grid.sync();
#define SYNC(k) do { if (lo <= (k) && (k) + 1 < hi) xcd_barrier(xbar, wv); } while (0)
#define WSB(off) ((bf16_t*)(opq(a.ws) + (off)))
#define LDSL ((LAS unsigned char*)lds)
#ifndef NREP
#define NREP 1
#endif
#define REP for (int rep_ = 0; rep_ < NREP; ++rep_)

    if (IN(0)) REP {
        int ib = 0; float* scr = (float*)lds;
        prep_job(a, JOB_FN, 0, 1024, 1024, WSB(WS_WFN), scr, 0, ib, G, bid, wv);
        prep_job(a, JOB_DFT, 0, 256, 512, WSB(WS_DFT), scr, 0, ib, G, bid, wv);
        prep_job(a, JOB_DN, 0, 768, 1024, WSB(WS_WDN), scr, 0, ib, G, bid, wv);
        prep_job(a, JOB_UQ, 0, 1536, 256, WSB(WS_WUQ), scr, 0, ib, G, bid, wv);
        prep_job(a, JOB_UKV, 0, 2048, 256, WSB(WS_WUKV), scr, 0, ib, G, bid, wv);
        prep_job(a, JOB_WO, 0, 1024, 1024, WSB(WS_WO), scr, 0, ib, G, bid, wv);
        prep_job(a, JOB_GU, 0, 5632, 1024, WSB(WS_WGU), scr, 0, ib, G, bid, wv);
        prep_job(a, JOB_FD, 0, 1024, 2816, WSB(WS_WFD), scr, 0, ib, G, bid, wv);
        float* rope = (float*)WSB(WS_ROPE);
        for (int e = bid * 512 + otid(wv); e < 16384 * 32; e += G * 512) { const int pos = e >> 5, i = e & 31;
            const float inv = 1.0f / powf(10000.0f, (float)(2 * i) / 64.0f); const float ang = (float)pos * inv;
            const double rev = (double)ang * 0.15915494309189535; const float fr = (float)(rev - floor(rev));
            rope[(size_t)e * 2] = cos2pi(fr); rope[(size_t)e * 2 + 1] = sin2pi(fr); }
        row_first(a, WSB(WS_H), G, bid, wv);
    }
    SYNC(0);
    if (IN(1)) REP fft::fft_phase<128, 1>((char*)lds, WSB(WS_H), WSB(WS_TP), 2, G, bid, wv);
    SYNC(1);
    if (IN(2)) REP fft::fft_phase<128, 2>((char*)lds, WSB(WS_TP), WSB(WS_PQ), 2, G, bid, wv);
    SYNC(2);
    if (IN(3)) REP { pg8::Gemm g{WSB(WS_PQ), WSB(WS_DFT), T_HALF, 1024, 512, 2048, 1024, 1, 0}; pg8::StaticOrder S; S.init(T_HALF, 1024, G, bid);
        pg8::EpiStore E{WSB(WS_H), 1024, nullptr, nullptr}; pg8::gemm_phase(LDSL, g, S, E, wv); }
    if (IN(4)) REP fft::fft_phase<64, 1>((char*)lds, WSB(WS_H) + (size_t)T_HALF * 1024, WSB(WS_TP), 8, G, bid, wv);
    SYNC(4);
    if (IN(5)) REP fft::fft_phase<64, 2>((char*)lds, WSB(WS_TP), WSB(WS_PQ), 8, G, bid, wv);
    SYNC(5);
    if (IN(6)) REP { pg8::Gemm g{WSB(WS_PQ), WSB(WS_DFT), T_HALF, 1024, 512, 2048, 1024, 1, 0}; pg8::StaticOrder S; S.init(T_HALF, 1024, G, bid);
        pg8::EpiStore E{WSB(WS_H) + (size_t)T_HALF * 1024, 1024, nullptr, nullptr}; pg8::gemm_phase(LDSL, g, S, E, wv); }
    SYNC(6);
    if (IN(7)) REP { pg8::Gemm g{WSB(WS_H), WSB(WS_WFN), T_ALL, 1024, 1024, 1024, 0, 0, 0}; pg8::StaticOrder S; S.init(T_ALL, 1024, G, bid);
        pg8::EpiStore E{WSB(WS_M), 1024, a.fnet_b, nullptr}; pg8::gemm_phase(LDSL, g, S, E, wv); }
    SYNC(7);
    if (IN(8)) REP row_mid(WSB(WS_M), a.norm_g + 1 * 1024, a.xp, a.xs, nullptr, (bf16_t*)a.out, (float*)WSB(WS_RSTD), nullptr, G, bid, wv);
    SYNC(8);
#define FFN_PHASES(base, layer, last) \
    for (int hf = 0; hf < 2; ++hf) { \
        if (IN((base) + 2 * hf)) REP { const bf16_t* xres = (layer) ? (const bf16_t*)WSB(WS_H) : (const bf16_t*)a.out;     \
            pg8::Gemm g{xres + (size_t)hf * T_HALF * 1024, WSB(WS_WGU), T_HALF, 5632, 1024, 1024, 0, 0, 0}; pg8::StaticOrder S; S.init(T_HALF, 5632, G, bid); \
            pg8::EpiSwiGLU E{WSB(WS_ACT), (const float*)WSB(WS_RSTD) + (size_t)hf * T_HALF}; pg8::gemm_phase(LDSL, g, S, E, wv); } \
        SYNC((base) + 2 * hf); \
        if (IN((base) + 2 * hf + 1)) REP { pg8::Gemm g{WSB(WS_ACT), WSB(WS_WFD), T_HALF, 1024, DFF, DFF, 0, 0, 0}; pg8::StaticOrder S; S.init(T_HALF, 1024, G, bid); \
            pg8::EpiStore E{WSB(WS_F) + (size_t)hf * T_HALF * 1024, 1024, nullptr, nullptr}; pg8::gemm_phase(LDSL, g, S, E, wv); } \
        SYNC((base) + 2 * hf + 1); \
    } \
    if (IN((base) + 4)) { if (last) row_mid(WSB(WS_F), a.norm_g + ((layer) * 4 + 3) * 1024, nullptr, nullptr, WSB(WS_H), nullptr, nullptr, a.out, G, bid, wv); \
                          else row_mid(WSB(WS_F), a.norm_g + ((layer) * 4 + 3) * 1024, nullptr, nullptr, (const bf16_t*)a.out, (bf16_t*)a.out, (float*)WSB(WS_RSTD), nullptr, G, bid, wv); } \
    SYNC((base) + 4);
#pragma unroll 1
    for (int layer = 0; layer < 2; ++layer) {
        const int base = layer ? 22 : 9;
        if (layer == 1) {
            if (IN(14)) REP { pg8::Gemm g{(const bf16_t*)a.out, WSB(WS_WDN), T_ALL, 768, 1024, 1024, 0, 0, 0}; pg8::StaticOrder S; S.init(T_ALL, 768, G, bid);
                pg8::EpiStore E{WSB(WS_DOWN), 768, nullptr, (const float*)WSB(WS_RSTD)}; pg8::gemm_phase(LDSL, g, S, E, wv); }
            SYNC(14);
            if (IN(15)) REP {
                row_mla(WSB(WS_DOWN), (const float*)WSB(WS_ROPE), WSB(WS_CQ), WSB(WS_CKV), WSB(WS_KR), G, bid, wv);
                int ib = 0; float* scr = (float*)lds;
                prep_job(a, JOB_GU, 1, 5632, 1024, WSB(WS_WGU), scr, 0, ib, G, bid, wv);
                prep_job(a, JOB_FD, 1, 1024, 2816, WSB(WS_WFD), scr, 0, ib, G, bid, wv);
                __syncthreads();
            }
            SYNC(15);
            if (IN(16)) REP { pg8::Gemm g{WSB(WS_CQ), WSB(WS_WUQ), T_ALL, 1536, 256, 256, 0, 0, 0}; pg8::StaticOrder S; S.init(T_ALL, 1536, G, bid);
                pg8::EpiStore E{WSB(WS_Q), 1536, nullptr, nullptr}; pg8::gemm_phase(LDSL, g, S, E, wv); }
#define KN_OF(hf) ((hf) ? (bf16_t*)((unsigned char*)a.out + 128 * MiB) : WSB(WS_KN))
#define V_OF(hf)  ((hf) ? (bf16_t*)((unsigned char*)a.out + 192 * MiB) : WSB(WS_V))
#pragma unroll 1
            for (int hf = 0; hf < 2; ++hf) {
                if (IN(16)) REP { pg8::Gemm g{WSB(WS_CKV) + (size_t)hf * T_HALF * 256, WSB(WS_WUKV), T_HALF, 2048, 256, 256, 0, 0, 0}; pg8::StaticOrder S; S.init(T_HALF, 2048, G, bid);
                    pg8::EpiKV E{KN_OF(hf), V_OF(hf)}; pg8::gemm_phase(LDSL, g, S, E, wv); }
            }
            SYNC(16);
            if (IN(17)) {
#pragma unroll 1
                for (int hf = 0; hf < 2; ++hf) {
                    const int xcd = bid & 7, slot = bid >> 3;
                    for (int it = 0; it * G < 1024; ++it) {
                        int combo, qb;
                        if (G == 256) { if (hf == 0) { combo = it * 4 + (xcd >> 1); qb = (xcd & 1) * 32 + slot; } else { combo = it * 16 + xcd * 2 + (slot >> 4); qb = slot & 15; } }
                        else { const int u = it * G + bid; if (u >= 1024) break; if (hf == 0) { combo = u >> 6; qb = u & 63; } else { combo = u >> 4; qb = u & 15; } }
                        const int bt = combo >> 3, hh = combo & 7; const int seq = hf ? S_S : S_P;
                        const size_t tloc = (size_t)bt * seq, tglob = (size_t)hf * T_HALF + tloc;
                        bf16_t* qp = WSB(WS_Q) + (tglob + (size_t)qb * 256) * 1536 + hh * 192;
                        att::attn_unit(qp, KN_OF(hf) + tloc * 1024 + hh * 128, WSB(WS_KR) + tglob * 64, V_OF(hf) + tloc * 1024 + hh * 128, qp, seq, (char*)lds, wv, (const float*)WSB(WS_ROPE), qb * 256);
                    }
                }
            }
            SYNC(17);
#undef KN_OF
#undef V_OF
            if (IN(20)) REP { pg8::Gemm g{WSB(WS_Q), WSB(WS_WO), T_ALL, 1024, 1024, 1536, 0, 0, 1}; pg8::StaticOrder S; S.init(T_ALL, 1024, G, bid);
                pg8::EpiStore E{WSB(WS_M2), 1024, nullptr, nullptr}; pg8::gemm_phase(LDSL, g, S, E, wv); }
            SYNC(20);
            if (IN(21)) row_mid(WSB(WS_M2), a.norm_g + (4 + 1) * 1024, nullptr, nullptr, (const bf16_t*)a.out, WSB(WS_H), (float*)WSB(WS_RSTD), nullptr, G, bid, wv);
            SYNC(21);
        }
        FFN_PHASES(base, layer, layer == 1)
    }
#ifdef DBG_OFF
    if (hi >= 27) { grid.sync(); const bf16_t* sp = WSB(DBG_OFF);
        for (size_t i = (size_t)bid * 512 + otid(wv); i < (size_t)T_ALL * 1024; i += (size_t)G * 512) a.out[i] = bf2f(sp[i]); }
#endif
#undef IN
#undef SYNC
}

extern "C" void kernel_launch(void* const* d_in, const int* in_sizes, int n_in, void* d_out, int out_size, void* d_ws, size_t ws_size, hipStream_t stream) {
    static int grid = 0;
    if (grid == 0) {
        if (n_in != 14 || out_size != T_ALL * DM || ws_size < WS_END) { fprintf(stderr, "kernel_launch: unexpected shapes (n_in %d out %d ws %zu)\n", n_in, out_size, ws_size); grid = -1; return; }
        int dev = 0, cus = 0, per_cu = 0;
        (void)hipGetDevice(&dev); (void)hipDeviceGetAttribute(&cus, hipDeviceAttributeMultiprocessorCount, dev);
        if (hipFuncSetAttribute((const void*)mega, hipFuncAttributeMaxDynamicSharedMemorySize, LDS_BYTES) != hipSuccess) { fprintf(stderr, "kernel_launch: hipFuncSetAttribute failed\n"); grid = -1; return; }
        (void)hipOccupancyMaxActiveBlocksPerMultiprocessor(&per_cu, (const void*)mega, 512, LDS_BYTES);
        (void)hipGetLastError();
        if (per_cu < 1) per_cu = 1;
        grid = cus * 1;
    }
    if (grid < 0) return;
    Args a{};
    a.xp = (const float*)d_in[0]; a.xs = (const float*)d_in[1]; a.norm_g = (const float*)d_in[2]; a.fnet_w = (const float*)d_in[3]; a.fnet_b = (const float*)d_in[4];
    a.w_down = (const float*)d_in[5]; a.q_norm = (const float*)d_in[6]; a.w_uq = (const float*)d_in[7]; a.kv_norm = (const float*)d_in[8]; a.w_ukv = (const float*)d_in[9];
    a.w_o = (const float*)d_in[10]; a.w_gate = (const float*)d_in[11]; a.w_up = (const float*)d_in[12]; a.w_fdown = (const float*)d_in[13];
    a.out = (float*)d_out; a.ws = (unsigned char*)d_ws; a.ph_lo = 0; a.ph_hi = NPHASE;
    if (hipMemsetAsync(d_ws, 0, 16384, stream) != hipSuccess) { fprintf(stderr, "kernel_launch: memset failed\n"); return; }
    void* args[] = {&a};
    hipError_t e = hipLaunchCooperativeKernel((const void*)mega, dim3(grid), dim3(512), args, LDS_BYTES, stream);
    if (e != hipSuccess) fprintf(stderr, "cooperative launch failed: %s (grid %d)\n", hipGetErrorString(e), grid);
}
```

```cpp
#include <hip/hip_runtime.h>
#include <hip/hip_cooperative_groups.h>
#include <cstdint>
#include <cstdio>
namespace cg = cooperative_groups;

#define DI __device__ __forceinline__
#define LAS __attribute__((address_space(3)))
typedef unsigned short bf16_t;
typedef short bf16x8 __attribute__((ext_vector_type(8)));
typedef short s16x4 __attribute__((ext_vector_type(4)));
typedef float f32x4 __attribute__((ext_vector_type(4)));
typedef float f32x16 __attribute__((ext_vector_type(16)));
typedef unsigned u32x4 __attribute__((ext_vector_type(4)));
typedef unsigned u32x2 __attribute__((ext_vector_type(2)));

constexpr int T_ALL = 65536, T_HALF = 32768, DM = 1024, DFF = 2816;
constexpr int S_P = 16384, S_S = 4096;
constexpr float NORM_EPS = 1e-6f;
constexpr float QSCALE = 0.07216878364870322f * 1.4426950408889634f;

constexpr size_t MiB = 1u << 20;
constexpr size_t WS_ROPE = 1 * MiB;
constexpr size_t WS_WFN  = 5 * MiB;
constexpr size_t WS_DFT  = 7 * MiB;
constexpr size_t WS_WDN  = 7 * MiB + 512 * 1024;
constexpr size_t WS_WUQ  = 9 * MiB;
constexpr size_t WS_WUKV = 10 * MiB;
constexpr size_t WS_WO   = 11 * MiB;
constexpr size_t WS_WGU  = 14 * MiB;
constexpr size_t WS_WFD  = 25 * MiB;
constexpr size_t WS_RSTD = 31 * MiB;
constexpr size_t WS_H    = 32 * MiB;
constexpr size_t WS_G    = 160 * MiB;
constexpr size_t WS_TP   = WS_G;
constexpr size_t WS_PQ   = WS_G + 128 * MiB;
constexpr size_t WS_M    = WS_G;
constexpr size_t WS_ACT  = WS_G;
constexpr size_t WS_F    = WS_G + 176 * MiB;
constexpr size_t WS_DOWN = WS_G;
constexpr size_t WS_CQ   = WS_G + 96 * MiB;
constexpr size_t WS_CKV  = WS_G + 128 * MiB;
constexpr size_t WS_KR   = WS_G + 160 * MiB;
constexpr size_t WS_Q    = 32 * MiB;
constexpr size_t WS_KN   = WS_G + 176 * MiB;
constexpr size_t WS_V    = WS_G + 240 * MiB;
constexpr size_t WS_M2   = WS_G + 176 * MiB;
constexpr size_t WS_END  = 464 * MiB;

DI int otid(int wv) { int l; asm volatile("v_mbcnt_lo_u32_b32 %0, -1, 0\n\tv_mbcnt_hi_u32_b32 %0, -1, %0" : "=v"(l)); return wv * 64 + l; }
typedef float f32x2_t __attribute__((ext_vector_type(2)));
typedef __bf16 bf16x2_t __attribute__((ext_vector_type(2)));
DI unsigned cvt_pk_bf16(float lo, float hi) { const f32x2_t v = {lo, hi}; const bf16x2_t b = __builtin_convertvector(v, bf16x2_t); return __builtin_bit_cast(unsigned, b); }
DI bf16_t f2bf(float x) { return (bf16_t)(cvt_pk_bf16(x, x) & 0xffffu); }
DI float bf2f(unsigned b) { return __uint_as_float(b << 16); }
DI float wave_sum(float v) {
#pragma unroll
    for (int o = 1; o < 64; o <<= 1) v += __shfl_xor(v, o);
    return v;
}
#define GAS __attribute__((address_space(1)))
DI bf16x8 gld_bf8(const void* p) { return *(const GAS bf16x8*)p; }
DI u32x4 gld_u4(const void* p) { return *(const GAS u32x4*)p; }
DI f32x4 gld_f4(const void* p) { return *(const GAS f32x4*)p; }
DI void gst_u4(void* p, u32x4 v) { *(GAS u32x4*)p = v; }
DI void gst_u2(void* p, u32x2 v) { *(GAS u32x2*)p = v; }
DI void gst_f4(void* p, f32x4 v) { *(GAS f32x4*)p = v; }
DI void gst_h(void* p, bf16_t v) { *(GAS bf16_t*)p = v; }
DI float cos2pi(float frac) { return __builtin_amdgcn_cosf(frac); }
DI float sin2pi(float frac) { return __builtin_amdgcn_sinf(frac); }

namespace pg8 {
constexpr int BM = 256, BK = 64, HALF = 128, HTB = HALF * BK * 2, STAGE_BYTES = 8 * HTB, NXCD = 8, WGM = 8;
DI int lds_byte(int r, int c) { const int st = (r >> 4) * 2 + (c >> 5), rr = r & 15, cc = c & 31, ob = rr * 64 + cc * 2; return st * 1024 + (ob ^ (((ob >> 9) & 1) << 5)); }
DI void stage_rc(int b, int& R, int& C) { const int st = b / 1024, sb = b % 1024, swz = sb ^ (((sb >> 9) & 1) << 5); R = (st >> 1) * 16 + swz / 64; C = (st & 1) * 32 + (swz % 64) / 2; }
DI int perm32(int rho) { const int n = rho >> 4, i = rho & 15; return 8 * (i >> 2) + 4 * n + (i & 3); }

struct Unit { int pm, pn; };
struct Gemm { const bf16_t* A; const bf16_t* Bt; int M, N, K, lda; long a_pn_off; int b_shared; int askip; };

struct StaticOrder {
    int nM, nN, nwg, G, c;
    DI void init(int M, int N, int G_, int c_) { nM = M / BM; nN = N / BM; nwg = nM * nN; G = G_; c = c_; }
    DI bool next(int i, Unit& u) const {
        const long L = (long)i * G + c; if (L >= nwg) return false;
        int wgid = (int)L; { const int q = nwg / NXCD, r = nwg % NXCD, xcd = wgid % NXCD, off = wgid / NXCD; wgid = (xcd < r ? xcd * (q + 1) : r * (q + 1) + (xcd - r) * q) + off; }
        const int nig = WGM * nN, gid = wgid / nig, fm = gid * WGM, gsz = (nM - fm) < WGM ? (nM - fm) : WGM;
        u.pm = fm + ((wgid % nig) % gsz); u.pn = (wgid % nig) / gsz; return true;
    }
};

struct EpiStore {
    bf16_t* O; int ldc; const float* bias; const float* rs;
    DI void operator()(const f32x4 (&acc)[2][2][4][2], const Unit& u, int wr, int wc, int fr, int fq) const {
        const int row0 = u.pm * BM + wr * 64 + fr; const int col0 = u.pn * BM + wc * 32 + 8 * fq;
        f32x4 bv[2][2];
#pragma unroll
        for (int bj = 0; bj < 2; ++bj)
#pragma unroll
            for (int n = 0; n < 2; ++n) bv[bj][n] = bias ? *(const f32x4*)(bias + col0 + bj * HALF + 4 * n) : (f32x4){0.f, 0.f, 0.f, 0.f};
#pragma unroll
        for (int ai = 0; ai < 2; ++ai)
#pragma unroll
            for (int m = 0; m < 4; ++m) { const int row = row0 + ai * HALF + m * 16; bf16_t* rowp = O + (size_t)row * ldc + col0;
                const float sc = rs ? rs[row] : 1.f;
#pragma unroll
                for (int bj = 0; bj < 2; ++bj) { f32x4 v0 = (acc[ai][bj][m][0] + bv[bj][0]) * sc, v1 = (acc[ai][bj][m][1] + bv[bj][1]) * sc;
                    u32x4 w; w.x = cvt_pk_bf16(v0[0], v0[1]); w.y = cvt_pk_bf16(v0[2], v0[3]); w.z = cvt_pk_bf16(v1[0], v1[1]); w.w = cvt_pk_bf16(v1[2], v1[3]);
                    *(u32x4*)(rowp + bj * HALF) = w; } }
    }
};
DI float silu_mul(float g, float u) { return g * __builtin_amdgcn_rcpf(1.f + __builtin_amdgcn_exp2f(-1.4426950408889634f * g)) * u; }
struct EpiSwiGLU {
    bf16_t* O; const float* rs;
    DI void operator()(const f32x4 (&acc)[2][2][4][2], const Unit& u, int wr, int wc, int fr, int fq) const {
        const int row0 = u.pm * BM + wr * 64 + fr; const int col0 = u.pn * HALF + wc * 32 + 8 * fq;
#pragma unroll
        for (int ai = 0; ai < 2; ++ai)
#pragma unroll
            for (int m = 0; m < 4; ++m) { const int row = row0 + ai * HALF + m * 16; bf16_t* rowp = O + (size_t)row * DFF + col0; const float sc = rs[row];
                const f32x4 g0 = acc[ai][0][m][0] * sc, g1 = acc[ai][0][m][1] * sc, u0 = acc[ai][1][m][0] * sc, u1 = acc[ai][1][m][1] * sc;
                u32x4 w; w.x = cvt_pk_bf16(silu_mul(g0[0], u0[0]), silu_mul(g0[1], u0[1])); w.y = cvt_pk_bf16(silu_mul(g0[2], u0[2]), silu_mul(g0[3], u0[3]));
                w.z = cvt_pk_bf16(silu_mul(g1[0], u1[0]), silu_mul(g1[1], u1[1])); w.w = cvt_pk_bf16(silu_mul(g1[2], u1[2]), silu_mul(g1[3], u1[3]));
                *(u32x4*)rowp = w; }
    }
};
struct EpiQ {
    bf16_t* O; const float* rope;
    DI void operator()(const f32x4 (&acc)[2][2][4][2], const Unit& u, int wr, int wc, int fr, int fq) const {
        const int row0 = u.pm * BM + wr * 64 + fr;
#pragma unroll
        for (int ai = 0; ai < 2; ++ai)
#pragma unroll
            for (int m = 0; m < 4; ++m) { const int row = row0 + ai * HALF + m * 16; const int pos = row < T_HALF ? (row & (S_P - 1)) : (row & (S_S - 1));
#pragma unroll
                for (int bj = 0; bj < 2; ++bj) { const int cb32 = u.pn * BM + bj * HALF + wc * 32, c0 = cb32 + 8 * fq; const int hcb = cb32 % 192;
                    f32x4 v0 = acc[ai][bj][m][0], v1 = acc[ai][bj][m][1];
                    if (hcb >= 128) { const int t = ((hcb - 128) >> 3) + fq; const float* cs = rope + ((size_t)pos * 32 + 4 * t) * 2;
                        const f32x4 a = *(const f32x4*)cs, b = *(const f32x4*)(cs + 4);
                        const f32x4 cv = {a[0], a[2], b[0], b[2]}, sv = {a[1], a[3], b[1], b[3]};
                        const f32x4 o1 = v0 * cv - v1 * sv, o2 = v1 * cv + v0 * sv; v0 = o1; v1 = o2; }
                    u32x4 w; w.x = cvt_pk_bf16(v0[0], v0[1]); w.y = cvt_pk_bf16(v0[2], v0[3]); w.z = cvt_pk_bf16(v1[0], v1[1]); w.w = cvt_pk_bf16(v1[2], v1[3]);
                    *(u32x4*)(O + (size_t)row * 1536 + c0) = w; }
                __builtin_amdgcn_sched_barrier(0); }
    }
};
struct EpiKV {
    bf16_t* Kn; bf16_t* V;
    DI void operator()(const f32x4 (&acc)[2][2][4][2], const Unit& u, int wr, int wc, int fr, int fq) const {
        const int row0 = u.pm * BM + wr * 64 + fr; const int col0 = u.pn * HALF + wc * 32 + 8 * fq;
#pragma unroll
        for (int ai = 0; ai < 2; ++ai)
#pragma unroll
            for (int m = 0; m < 4; ++m) { const size_t off = (size_t)(row0 + ai * HALF + m * 16) * 1024 + col0;
#pragma unroll
                for (int bj = 0; bj < 2; ++bj) { const f32x4 v0 = acc[ai][bj][m][0], v1 = acc[ai][bj][m][1];
                    u32x4 w; w.x = cvt_pk_bf16(v0[0], v0[1]); w.y = cvt_pk_bf16(v0[2], v0[3]); w.z = cvt_pk_bf16(v1[0], v1[1]); w.w = cvt_pk_bf16(v1[2], v1[3]);
                    *(u32x4*)((bj ? V : Kn) + off) = w; } }
    }
};

template <class Epi>
DI void gemm_phase(LAS unsigned char* lds, const Gemm g, const StaticOrder& S, const Epi& E, int wv) {
    const int tid = otid(wv), wid = __builtin_amdgcn_readfirstlane(tid >> 6), lane = tid & 63, wr = wid >> 2, wc = wid & 3, fr = lane & 15, fq = lane >> 4;
    int K = g.K; asm volatile("" : "+s"(K));
    const int nt = K / BK;
    unsigned voffA[2], voffB[2];
#pragma unroll
    for (int i = 0; i < 2; ++i) { int R, C; stage_rc(tid * 16 + i * 8192, R, C); const int Rb = (R & ~31) + perm32(R & 31);
        voffA[i] = (unsigned)(R * g.lda + C) * 2u; voffB[i] = (unsigned)(Rb * K + C) * 2u; }
    const size_t kstep = (size_t)(BK * 2);
    const size_t hA = (size_t)HALF * g.lda * 2, tA = 2 * hA;
    const size_t hB = (size_t)HALF * K * 2, tB = g.b_shared ? 0 : 2 * hB;
    const unsigned ldsw = (unsigned)wid * 1024u;
    const int aoff = lds_byte(wr * 64 + fr, fq * 8), boff = lds_byte(wc * 32 + fr, fq * 8);
#define PG8_SA(b, h) (((b) * 2 + (h)) * HTB)
#define PG8_SB(b, h) ((4 + (b) * 2 + (h)) * HTB)
#define PG8_STAGE(bufoff, gbase, voff) do { _Pragma("unroll") for (int _i = 0; _i < 2; ++_i) \
        __builtin_amdgcn_global_load_lds((const unsigned*)((const char*)(gbase) + (voff)[_i]), (LAS unsigned*)(lds + (bufoff) + ldsw + _i * 8192), 16, 0, 0); } while (0)
#define PG8_LDA(dst, b, h) do { _Pragma("unroll") for (int m = 0; m < 4; ++m) _Pragma("unroll") for (int k = 0; k < 2; ++k) dst[m][k] = *(const LAS bf16x8*)(lds + PG8_SA(b, h) + aoff + m * 2048 + k * 1024); } while (0)
#define PG8_LDB(dst, b, h) do { _Pragma("unroll") for (int n = 0; n < 2; ++n) _Pragma("unroll") for (int k = 0; k < 2; ++k) dst[n][k] = *(const LAS bf16x8*)(lds + PG8_SB(b, h) + boff + n * 2048 + k * 1024); } while (0)
#define PG8_MMA(ai, bj, At, Bt) do { __builtin_amdgcn_s_setprio(1); _Pragma("unroll") for (int m = 0; m < 4; ++m) _Pragma("unroll") for (int n = 0; n < 2; ++n) _Pragma("unroll") for (int k = 0; k < 2; ++k) \
        acc[ai][bj][m][n] = __builtin_amdgcn_mfma_f32_16x16x32_bf16(Bt[n][k], At[m][k], acc[ai][bj][m][n], 0, 0, 0); __builtin_amdgcn_s_setprio(0); } while (0)
#define PG8_WAIT_V(n) asm volatile("s_waitcnt vmcnt(" #n ")" ::: "memory")
#define PG8_WAIT_L(n) asm volatile("s_waitcnt lgkmcnt(" #n ")" ::: "memory")
#define PG8_BAR __builtin_amdgcn_s_barrier()
#define PG8_SCHED __builtin_amdgcn_sched_barrier(0)
    Unit cur, nxt; int ui = 0;
    if (!S.next(0, cur)) return;
    f32x4 acc[2][2][4][2];
#pragma unroll
    for (int a = 0; a < 2; ++a)
#pragma unroll
        for (int b = 0; b < 2; ++b)
#pragma unroll
            for (int m = 0; m < 4; ++m)
#pragma unroll
                for (int n = 0; n < 2; ++n) acc[a][b][m][n] = (f32x4){0.f, 0.f, 0.f, 0.f};
    bf16x8 At[4][2], B0[2][2], B1[2][2];
    const char* cA = (const char*)g.A + (size_t)cur.pm * tA + (size_t)cur.pn * g.a_pn_off; const char* cB = (const char*)g.Bt + (size_t)cur.pn * tB;
    PG8_STAGE(PG8_SB(0, 0), cB, voffB); PG8_STAGE(PG8_SB(0, 1), cB + hB, voffB); PG8_STAGE(PG8_SA(0, 0), cA, voffA); PG8_STAGE(PG8_SA(0, 1), cA + hA, voffA);
    if (wr == 1) PG8_BAR;
    PG8_WAIT_V(2); PG8_BAR;
    PG8_STAGE(PG8_SB(1, 0), cB + kstep, voffB); PG8_STAGE(PG8_SA(1, 0), cA + kstep, voffA); PG8_STAGE(PG8_SB(1, 1), cB + hB + kstep, voffB);
    PG8_WAIT_V(6); PG8_BAR;
    for (;;) {
        const bool has_next = S.next(ui + 1, nxt);
        const char* nA = has_next ? (const char*)g.A + (size_t)nxt.pm * tA + (size_t)nxt.pn * g.a_pn_off : cA; const char* nB = has_next ? (const char*)g.Bt + (size_t)nxt.pn * tB : cB;
        for (int t = 0; t < nt; t += 2) {
            const bool last = (t == nt - 2);
            const size_t sk1 = g.askip ? (size_t)((t + 1) >> 1) * kstep : 0, sk2 = g.askip ? (size_t)((t + 2) >> 1) * kstep : 0, sk3 = g.askip ? (size_t)((t + 3) >> 1) * kstep : 0;
            const char* a1 = cA + (size_t)(t + 1) * kstep + sk1;
            const char* a2 = last ? nA : cA + (size_t)(t + 2) * kstep + sk2; const char* b2 = last ? nB : cB + (size_t)(t + 2) * kstep;
            const char* a3 = last ? nA + kstep : cA + (size_t)(t + 3) * kstep + sk3; const char* b3 = b2 + kstep;
            PG8_LDB(B0, 0, 0); PG8_LDB(B1, 0, 1); PG8_SCHED; PG8_LDA(At, 0, 0); PG8_STAGE(PG8_SA(1, 1), a1 + hA, voffA);
            PG8_WAIT_V(8); PG8_WAIT_L(0); PG8_BAR; PG8_MMA(0, 0, At, B0); PG8_MMA(0, 1, At, B1); PG8_BAR; PG8_SCHED;
            PG8_LDA(At, 0, 1); PG8_STAGE(PG8_SB(0, 0), b2, voffB); PG8_STAGE(PG8_SB(0, 1), b2 + hB, voffB); PG8_STAGE(PG8_SA(0, 0), a2, voffA);
            PG8_WAIT_V(8); PG8_WAIT_L(0); PG8_BAR; PG8_MMA(1, 0, At, B0); PG8_MMA(1, 1, At, B1); PG8_BAR; PG8_SCHED;
            PG8_LDB(B0, 1, 0); PG8_LDB(B1, 1, 1); PG8_SCHED; PG8_LDA(At, 1, 0); PG8_STAGE(PG8_SA(0, 1), a2 + hA, voffA);
            PG8_WAIT_V(8); PG8_WAIT_L(0); PG8_BAR; PG8_MMA(0, 0, At, B0); PG8_MMA(0, 1, At, B1); PG8_BAR; PG8_SCHED;
            PG8_LDA(At, 1, 1); PG8_STAGE(PG8_SB(1, 0), b3, voffB); PG8_STAGE(PG8_SB(1, 1), b3 + hB, voffB); PG8_STAGE(PG8_SA(1, 0), a3, voffA);
            PG8_WAIT_V(8); PG8_WAIT_L(0); PG8_BAR; PG8_MMA(1, 0, At, B0); PG8_MMA(1, 1, At, B1); PG8_BAR; PG8_SCHED;
        }
        if (wr == 0) PG8_BAR;
        { const int l2 = otid(wv) & 63; E(acc, cur, wr, wc, l2 & 15, l2 >> 4); }
        if (!has_next) break;
#pragma unroll
        for (int a = 0; a < 2; ++a)
#pragma unroll
            for (int b = 0; b < 2; ++b)
#pragma unroll
                for (int m = 0; m < 4; ++m)
#pragma unroll
                    for (int n = 0; n < 2; ++n) acc[a][b][m][n] = (f32x4){0.f, 0.f, 0.f, 0.f};
        cur = nxt; cA = nA; cB = nB; ++ui;
        if (wr == 1) PG8_BAR;
    }
    PG8_WAIT_V(0);
    PG8_BAR;
#undef PG8_SA
#undef PG8_SB
#undef PG8_STAGE
#undef PG8_LDA
#undef PG8_LDB
#undef PG8_MMA
#undef PG8_WAIT_V
#undef PG8_WAIT_L
#undef PG8_BAR
#undef PG8_SCHED
}
}

namespace att {
constexpr int NW = 8, QBLK = 32, KVBLK = 64;
constexpr int SHM_V = KVBLK * 128 * 2, SHM_K = KVBLK * 192 * 2;
constexpr int NVS = 3;
constexpr int QR_OFF = NVS * SHM_V + 2 * SHM_K + NW * 64 * 4;
constexpr int LDS_BYTES = QR_OFF + NW * 4096;
constexpr float THR2 = 11.5415603f;
#define KSWZ(row, colB) ((row) * 384 + ((colB) ^ ((((row) >> 1) & 7) << 4)))
#define SBAR() __builtin_amdgcn_sched_barrier(0)
#define LDS_BARRIER() do { SBAR(); asm volatile("s_waitcnt lgkmcnt(0)" ::: "memory"); __builtin_amdgcn_s_barrier(); SBAR(); } while (0)
DI int crow(int r, int hi) { return (r & 3) + 8 * (r >> 2) + 4 * hi; }

DI void partialSM(f32x16& p0, f32x16& p1, float& m_reg, f32x16& negm, float& alpha, bool first) {
    float pmax = p0[0];
#pragma unroll
    for (int r = 1; r < 16; ++r) pmax = fmaxf(pmax, p0[r]);
#pragma unroll
    for (int r = 0; r < 16; ++r) pmax = fmaxf(pmax, p1[r]);
    { auto rr = __builtin_amdgcn_permlane32_swap(__float_as_uint(pmax), __float_as_uint(pmax), false, false);
      pmax = fmaxf(__uint_as_float(rr[0]), __uint_as_float(rr[1])); }
    if (__builtin_expect(!first && __all(pmax <= THR2), 1)) { alpha = 1.f; }
    else { const float delta = first ? pmax : fmaxf(pmax, 0.f); alpha = first ? 0.f : __builtin_amdgcn_exp2f(-delta); m_reg += delta;
#pragma unroll
        for (int r = 0; r < 16; ++r) { p0[r] = p0[r] - delta; p1[r] = p1[r] - delta; negm[r] = -m_reg; } }
#pragma unroll
    for (int r = 0; r < 16; ++r) p0[r] = __builtin_amdgcn_exp2f(p0[r]);
}
DI void finishSM(f32x16& p0, f32x16& p1, float alpha, float& l_reg, bf16x8& pa0, bf16x8& pa1, bf16x8& pa2, bf16x8& pa3) {
#pragma unroll
    for (int r = 0; r < 16; ++r) p1[r] = __builtin_amdgcn_exp2f(p1[r]);
    float ps = 0;
#pragma unroll
    for (int r = 0; r < 16; ++r) ps += p0[r];
#pragma unroll
    for (int r = 0; r < 16; ++r) ps += p1[r];
    { auto rr = __builtin_amdgcn_permlane32_swap(__float_as_uint(ps), __float_as_uint(ps), false, false);
      ps = __uint_as_float(rr[0]) + __uint_as_float(rr[1]); }
    l_reg = l_reg * alpha + ps;
#define PK4(P, BASE, OUT) do { unsigned a0 = cvt_pk_bf16(P[BASE + 0], P[BASE + 1]), a1 = cvt_pk_bf16(P[BASE + 2], P[BASE + 3]);   \
    unsigned b0 = cvt_pk_bf16(P[BASE + 4], P[BASE + 5]), b1 = cvt_pk_bf16(P[BASE + 6], P[BASE + 7]);                              \
    auto r0 = __builtin_amdgcn_permlane32_swap(a0, b0, false, false); auto r1 = __builtin_amdgcn_permlane32_swap(a1, b1, false, false); \
    u32x4 w = {r0[0], r1[0], r0[1], r1[1]}; OUT = *reinterpret_cast<bf16x8*>(&w); } while (0)
    PK4(p0, 0, pa0); PK4(p0, 8, pa1); PK4(p1, 0, pa2); PK4(p1, 8, pa3);
#undef PK4
}
DI void qkt(f32x16& p0, f32x16& p1, const f32x16& negm, const char* Ks, const bf16x8* qr, const char* qrl, const int (&kb)[4]) {
    bf16x8 b0[3], b1[3];
#define KLD(d) do { const char* kp_ = Ks + kb[(d) & 3] + ((d) >> 2) * 128; b0[(d) % 3] = *reinterpret_cast<const bf16x8*>(kp_); b1[(d) % 3] = *reinterpret_cast<const bf16x8*>(kp_ + 32 * 384); } while (0)
    KLD(0); KLD(1);
    __builtin_amdgcn_s_setprio(1);
#pragma unroll
    for (int d0 = 0; d0 < 12; ++d0) {
        if (d0 + 2 < 12) KLD(d0 + 2);
        SBAR();
        const bf16x8 qf = d0 < 8 ? qr[d0 < 8 ? d0 : 0] : *reinterpret_cast<const bf16x8*>(qrl + (d0 - 8) * 1024);
        p0 = __builtin_amdgcn_mfma_f32_32x32x16_bf16(b0[d0 % 3], qf, d0 == 0 ? negm : p0, 0, 0, 0);
        p1 = __builtin_amdgcn_mfma_f32_32x32x16_bf16(b1[d0 % 3], qf, d0 == 0 ? negm : p1, 0, 0, 0);
        SBAR(); }
    __builtin_amdgcn_s_setprio(0);
#undef KLD
}
DI int v_st(int k, int c) { const int kk = (k & ~0xC) | ((k & 4) << 1) | ((k & 8) >> 1); return ((kk >> 3) * 4 + (c >> 5)) * 512 + ((kk & 7) * 32 + (c & 31)) * 2; }
DI int v_rd_base(int lane) { return ((lane & 3) << 3) | (((lane >> 2) & 3) << 6) | (((lane >> 4) & 1) << 5) | (((lane >> 5) & 1) << 8); }
constexpr int v_rd_off(int d0, int ks, int half) { return d0 * 512 + ks * 4096 + half * 2048; }
template <int OFF> DI s16x4 tr_read(int vb) {
    s16x4 r; asm volatile("ds_read_b64_tr_b16 %0, %1 offset:%2" : "=&v"(r) : "v"(vb), "i"(OFF) : "memory"); return r;
}
#define PV_READS(D0, L0, H0, L1, H1, L2, H2, L3, H3) do { L0 = tr_read<v_rd_off(D0, 0, 0)>(vb); H0 = tr_read<v_rd_off(D0, 0, 1)>(vb); L1 = tr_read<v_rd_off(D0, 1, 0)>(vb); H1 = tr_read<v_rd_off(D0, 1, 1)>(vb); \
    L2 = tr_read<v_rd_off(D0, 2, 0)>(vb); H2 = tr_read<v_rd_off(D0, 2, 1)>(vb); L3 = tr_read<v_rd_off(D0, 3, 0)>(vb); H3 = tr_read<v_rd_off(D0, 3, 1)>(vb); } while (0)
#define PK(L, H) (bf16x8){L[0], L[1], L[2], L[3], H[0], H[1], H[2], H[3]}
#define PV_MMA(od, L0, H0, L1, H1, L2, H2, L3, H3) do { od = __builtin_amdgcn_mfma_f32_32x32x16_bf16(pa0, PK(L0, H0), od, 0, 0, 0); od = __builtin_amdgcn_mfma_f32_32x32x16_bf16(pa1, PK(L1, H1), od, 0, 0, 0); \
    od = __builtin_amdgcn_mfma_f32_32x32x16_bf16(pa2, PK(L2, H2), od, 0, 0, 0); od = __builtin_amdgcn_mfma_f32_32x32x16_bf16(pa3, PK(L3, H3), od, 0, 0, 0); } while (0)
DI void pv_d0(f32x16* o, int vb, bf16x8 pa0, bf16x8 pa1, bf16x8 pa2, bf16x8 pa3) {
    s16x4 a0, a1, a2, a3, a4, a5, a6, a7, b0, b1, b2, b3, b4, b5, b6, b7;
    PV_READS(0, a0, a1, a2, a3, a4, a5, a6, a7);
    PV_READS(1, b0, b1, b2, b3, b4, b5, b6, b7);
    asm volatile("s_waitcnt lgkmcnt(8)" ::: "memory"); SBAR();
    PV_MMA(o[0], a0, a1, a2, a3, a4, a5, a6, a7); SBAR();
    PV_READS(2, a0, a1, a2, a3, a4, a5, a6, a7);
    asm volatile("s_waitcnt lgkmcnt(8)" ::: "memory"); SBAR();
    PV_MMA(o[1], b0, b1, b2, b3, b4, b5, b6, b7); SBAR();
    PV_READS(3, b0, b1, b2, b3, b4, b5, b6, b7);
    asm volatile("s_waitcnt lgkmcnt(8)" ::: "memory"); SBAR();
    PV_MMA(o[2], a0, a1, a2, a3, a4, a5, a6, a7); SBAR();
    asm volatile("s_waitcnt lgkmcnt(0)" ::: "memory"); SBAR();
    PV_MMA(o[3], b0, b1, b2, b3, b4, b5, b6, b7);
}
#undef PV_READS
#undef PV_MMA
#undef PK

DI void attn_unit(const bf16_t* __restrict__ Qb, const bf16_t* __restrict__ Kn, const bf16_t* __restrict__ Kr, const bf16_t* __restrict__ Vh,
                  bf16_t* Ob, int seq, char* lds, int wv, const float* __restrict__ rope, int pos0) {
    const int tid = otid(wv), wid = tid >> 6, lane = tid & 63, r32 = lane & 31, hi = lane >> 5;
    char* V_lds = lds; char* K_lds = lds + NVS * SHM_V;
    float* ws = (float*)(lds + NVS * SHM_V + 2 * SHM_K) + wid * 64; float* li_l = ws; float* al_l = ws + 32;
    float m_reg = 0.f, l_reg = 0; f32x16 o[4]; bf16x8 qr[8]; f32x16 negm;
#pragma unroll
    for (int r = 0; r < 16; ++r) negm[r] = 0.f;
    char* qrl = lds + QR_OFF + wid * 4096 + lane * 16;
#pragma unroll
    for (int d = 0; d < 4; ++d)
#pragma unroll
        for (int r = 0; r < 16; ++r) o[d][r] = 0.f;
    const bf16_t* Qw = Qb + (size_t)(wid * QBLK + r32) * 1536 + hi * 8;
#pragma unroll
    for (int d0 = 0; d0 < 8; ++d0) qr[d0] = gld_bf8(Qw + d0 * 16);
#pragma unroll
    for (int d0 = 8; d0 < 12; ++d0) {
        const u32x4 raw = gld_u4(Qw + d0 * 16);
        const float* cs = rope + ((size_t)(pos0 + wid * QBLK + r32) * 32 + 4 * (2 * (d0 - 8) + hi)) * 2;
        const f32x4 ca = gld_f4(cs), cb = gld_f4(cs + 4);
        const float x10 = bf2f(raw.x & 0xffff), x11 = bf2f(raw.x >> 16), x12 = bf2f(raw.y & 0xffff), x13 = bf2f(raw.y >> 16);
        const float x20 = bf2f(raw.z & 0xffff), x21 = bf2f(raw.z >> 16), x22 = bf2f(raw.w & 0xffff), x23 = bf2f(raw.w >> 16);
        u32x4 w;
        w.x = cvt_pk_bf16(x10 * ca[0] - x20 * ca[1], x11 * ca[2] - x21 * ca[3]); w.y = cvt_pk_bf16(x12 * cb[0] - x22 * cb[1], x13 * cb[2] - x23 * cb[3]);
        w.z = cvt_pk_bf16(x20 * ca[0] + x10 * ca[1], x21 * ca[2] + x11 * ca[3]); w.w = cvt_pk_bf16(x22 * cb[0] + x12 * cb[1], x23 * cb[2] + x13 * cb[3]);
        *reinterpret_cast<u32x4*>(qrl + (d0 - 8) * 1024) = w; }
    const int sr = tid >> 4, sc = (tid & 15) * 8, vst0 = v_st(sr, sc), vst1 = v_st(32 + sr, sc);
    const int kr_ = tid >> 3, kc = (tid & 7) * 8;
    const int kst0 = KSWZ(kr_, kc * 2), kst1 = KSWZ(kr_, (64 + kc) * 2), kst2 = KSWZ(kr_, (128 + kc) * 2);
    const int vb0 = (int)(uintptr_t)V_lds + v_rd_base(lane);
    int kb[4];
#pragma unroll
    for (int i = 0; i < 4; ++i) kb[i] = KSWZ(r32, (i * 16 + hi * 8) * 2);
    bf16x8 vs0, vs1, ks0, ks1, ks2;
    const unsigned offV0 = (unsigned)(sr * 1024 + sc) * 2u, offK0 = (unsigned)(kr_ * 1024 + kc) * 2u, offR = (unsigned)(kr_ * 64 + kc) * 2u;
#define SLOAD(k0) do { const char* vt_ = (const char*)(Vh + (size_t)(k0) * 1024); const char* kt_ = (const char*)(Kn + (size_t)(k0) * 1024); const char* rt_ = (const char*)(Kr + (size_t)(k0) * 64); \
    vs0 = gld_bf8(vt_ + offV0); vs1 = gld_bf8(vt_ + offV0 + 65536u); \
    ks0 = gld_bf8(kt_ + offK0); ks1 = gld_bf8(kt_ + offK0 + 128u); \
    ks2 = gld_bf8(rt_ + offR); } while (0)
#define SWRITE(vo, ko) do { *(bf16x8*)(V_lds + (vo) + vst0) = vs0; *(bf16x8*)(V_lds + (vo) + vst1) = vs1; \
    *(bf16x8*)(K_lds + (ko) + kst0) = ks0; *(bf16x8*)(K_lds + (ko) + kst1) = ks1; *(bf16x8*)(K_lds + (ko) + kst2) = ks2; } while (0)
#define SWAIT() asm volatile("s_waitcnt vmcnt(0)" ::: "memory")
#define RESC(a) do { if (__any((a) < 1.f)) { if (hi == 0) al_l[r32] = (a); asm volatile("s_waitcnt lgkmcnt(0)" ::: "memory"); \
    _Pragma("unroll") for (int d = 0; d < 4; ++d) _Pragma("unroll") for (int r = 0; r < 16; ++r) o[d][r] *= al_l[crow(r, hi)]; } } while (0)
    f32x16 pA0, pA1; float alA; bf16x8 pa0, pa1, pa2, pa3; const int NT = seq / KVBLK;
    const bool grpB = (wv >= 4);
    int vcur = 0, kcur = 0;
    int vnxt = SHM_V, knxt = SHM_K;
#define STAGE_NEXT(jn) do { SWAIT(); SWRITE(vnxt, knxt); SBAR(); if ((jn) + 1 < NT) SLOAD(((jn) + 1) * KVBLK); SBAR(); asm volatile("s_waitcnt lgkmcnt(0)" ::: "memory"); __builtin_amdgcn_s_barrier(); SBAR(); } while (0)
    SLOAD(0); SWAIT(); SWRITE(0, 0); SBAR(); SLOAD(KVBLK); LDS_BARRIER();
    for (int j = 0; j < NT; ++j) {
        qkt(pA0, pA1, negm, K_lds + kcur, qr, qrl, kb); partialSM(pA0, pA1, m_reg, negm, alA, j == 0);
        RESC(alA);
        finishSM(pA0, pA1, alA, l_reg, pa0, pa1, pa2, pa3); SBAR();
        if (grpB && j + 1 < NT) STAGE_NEXT(j + 1);
        pv_d0(o, vb0 + vcur, pa0, pa1, pa2, pa3);
        SBAR();
        if (!grpB && j + 1 < NT) STAGE_NEXT(j + 1);
        vcur = vnxt; kcur = knxt; vnxt = (vnxt == (NVS - 1) * SHM_V) ? 0 : vnxt + SHM_V; knxt ^= SHM_K;
    }
#undef STAGE_NEXT
    if (hi == 0) li_l[r32] = l_reg; asm volatile("s_waitcnt lgkmcnt(0)" ::: "memory");
    bf16_t* Ow = Ob + (size_t)(wid * QBLK + 4 * hi) * 1536 + r32;
    asm volatile("" : "+v"(Ow));
#pragma unroll
    for (int r = 0; r < 16; ++r) { const int orow = crow(r, hi); const float rl = __builtin_amdgcn_rcpf(li_l[orow]);
        bf16_t* Or = Ow + ((r & 3) + 8 * (r >> 2)) * 1536;
#pragma unroll
        for (int d0 = 0; d0 < 4; ++d0) gst_h(Or + d0 * 32, f2bf(o[d0][r] * rl)); }
    LDS_BARRIER();
#undef SLOAD
#undef SWRITE
#undef SWAIT
#undef RESC
}
}

namespace fft {
DI s16x4 trr(unsigned addr) { s16x4 r; asm volatile("ds_read_b64_tr_b16 %0, %1" : "=&v"(r) : "v"(addr) : "memory"); return r; }
DI int crow(int r, int hi) { return (r & 3) + 8 * (r >> 2) + 4 * hi; }

template <int NN, int STAGE>
DI void fft_phase(char* lds, const bf16_t* __restrict__ src, bf16_t* __restrict__ dst, int nbatch, int G, int bid, int wv) {
    constexpr int S = NN * NN;
    constexpr int CW = (STAGE == 1) ? 256 : 128;
    constexpr int NCC = 1024 / CW;
    constexpr int KR = (STAGE == 1) ? NN : 2 * NN;
    constexpr int RS = CW * 2 + 64;
    constexpr int KS = KR / 16;
    constexpr int NROWT = NN / 16;
    constexpr int NCPART = 8 / NROWT;
    constexpr int NCBW = (CW / 32) / NCPART;
    constexpr int C16 = CW / 8;
    constexpr int NLD = KR * C16 / 512;
    const int tid = otid(wv), wid = tid >> 6, lane = tid & 63, m32 = lane & 31, h = lane >> 5;
    const int rt = wid % NROWT, cpart = wid / NROWT;
    const int nunits = nbatch * NN * NCC;
    bf16x8 areg[KS];
#pragma unroll
    for (int s = 0; s < KS; ++s) {
        float v[8];
#pragma unroll
        for (int j = 0; j < 8; ++j) { const int k = 16 * s + 8 * h + j;
            if (STAGE == 1) { const int c = 16 * rt + (m32 & 15), reim = m32 >> 4; const float fr = (float)((k * c) & (NN - 1)) * (1.0f / NN);
                v[j] = reim ? -sin2pi(fr) : cos2pi(fr); }
            else { const int R = 32 * rt + m32, ro = R / NN, d = R % NN, ri = k / NN, b = k % NN; const float fr = (float)((b * d) & (NN - 1)) * (1.0f / NN);
                const float cs = cos2pi(fr), sn = sin2pi(fr); v[j] = (ro == 0) ? (ri == 0 ? cs : sn) : (ri == 0 ? -sn : cs); } }
        u32x4 w = {cvt_pk_bf16(v[0], v[1]), cvt_pk_bf16(v[2], v[3]), cvt_pk_bf16(v[4], v[5]), cvt_pk_bf16(v[6], v[7])};
        areg[s] = *reinterpret_cast<bf16x8*>(&w);
    }
    const unsigned ldsb = (unsigned)(uintptr_t)lds;
    const int i16 = lane & 15, q = i16 >> 2, p = i16 & 3, blk = (lane >> 4) & 1;
    const unsigned rbase = ldsb + (unsigned)((8 * h + q) * RS + (16 * blk + 4 * p) * 2);
    u32x4 pre[NLD];
    auto unit_src = [&](int u, int& bt, int& x, int& cc) -> const bf16_t* {
        cc = u % NCC; const int t = u / NCC; x = t % NN; bt = t / NN;
        if (STAGE == 1) return src + ((size_t)bt * S + x) * 1024 + cc * CW;
        else return src + ((size_t)(bt * NN + x) * 2 * NN) * 1024 + cc * CW;
    };
    constexpr size_t ROWSTEP = (STAGE == 1) ? (size_t)NN * 1024 : 1024;
    int u = bid;
    if (u < nunits) { int bt, x, cc; const bf16_t* sp = unit_src(u, bt, x, cc);
#pragma unroll
        for (int i = 0; i < NLD; ++i) { const int ch = tid + i * 512, row = ch / C16, c16 = ch % C16; pre[i] = gld_u4(sp + (size_t)row * ROWSTEP + c16 * 8); } }
    for (; u < nunits; u += G) {
        int bt, x, cc; (void)unit_src(u, bt, x, cc);
        LDS_BARRIER();
#pragma unroll
        for (int i = 0; i < NLD; ++i) { const int ch = tid + i * 512, row = ch / C16, c16 = ch % C16; *(u32x4*)(lds + row * RS + c16 * 16) = pre[i]; }
        LDS_BARRIER();
        if (u + G < nunits) { int bt2, x2, cc2; const bf16_t* sp = unit_src(u + G, bt2, x2, cc2);
#pragma unroll
            for (int i = 0; i < NLD; ++i) { const int ch = tid + i * 512, row = ch / C16, c16 = ch % C16; pre[i] = gld_u4(sp + (size_t)row * ROWSTEP + c16 * 8); } }
        float tc[8], tsn[8];
        if (STAGE == 1) {
#pragma unroll
            for (int r = 0; r < 8; ++r) { const int c = 16 * rt + crow(r, h); const float fr = (float)((x * c) & (S - 1)) * (1.0f / S); tc[r] = cos2pi(fr); tsn[r] = sin2pi(fr); }
        }
#pragma unroll 1
        for (int cbi = 0; cbi < NCBW; ++cbi) {
            const int cb = cpart * NCBW + cbi;
            f32x16 acc;
#pragma unroll
            for (int r = 0; r < 16; ++r) acc[r] = 0.f;
            const unsigned cbase = rbase + (unsigned)(cb * 64);
#pragma unroll
            for (int s0 = 0; s0 < KS; s0 += 4) {
                s16x4 lo[4], hh[4];
#pragma unroll
                for (int i = 0; i < 4; ++i) { lo[i] = trr(cbase + (unsigned)((s0 + i) * 16 * RS)); hh[i] = trr(cbase + (unsigned)((s0 + i) * 16 * RS + 4 * RS)); }
                asm volatile("s_waitcnt lgkmcnt(0)" ::: "memory"); __builtin_amdgcn_sched_barrier(0);
#pragma unroll
                for (int i = 0; i < 4; ++i) { const bf16x8 bfr = (bf16x8){lo[i][0], lo[i][1], lo[i][2], lo[i][3], hh[i][0], hh[i][1], hh[i][2], hh[i][3]};
                    acc = __builtin_amdgcn_mfma_f32_32x32x16_bf16(areg[s0 + i], bfr, acc, 0, 0, 0); }
            }
            const int col = cc * CW + cb * 32 + m32;
            if (STAGE == 1) {
#pragma unroll
                for (int r = 0; r < 8; ++r) { const int c = 16 * rt + crow(r, h); const float tr_ = acc[r], ti = acc[r + 8];
                    const float o_r = tr_ * tc[r] + ti * tsn[r], o_i = ti * tc[r] - tr_ * tsn[r];
                    bf16_t* dp = dst + (((size_t)(bt * NN + c) * 2) * NN + x) * 1024 + col;
                    gst_h(dp, f2bf(o_r)); gst_h(dp + (size_t)NN * 1024, f2bf(o_i)); }
            } else {
#pragma unroll
                for (int r = 0; r < 16; ++r) { const int R = 32 * rt + crow(r, h), ro = R / NN, d = R % NN;
                    const size_t tok = (size_t)bt * S + x + (size_t)NN * d;
                    gst_h(dst + tok * 2048 + (col >> 8) * 512 + ro * 256 + (col & 255), f2bf(acc[r])); }
            }
        }
    }
    __syncthreads();
}
}

struct Args {
    const float* xp; const float* xs; const float* norm_g; const float* fnet_w; const float* fnet_b; const float* w_down; const float* q_norm; const float* w_uq;
    const float* kv_norm; const float* w_ukv; const float* w_o; const float* w_gate; const float* w_up; const float* w_fdown;
    float* out; unsigned char* ws; int ph_lo, ph_hi;
};

enum { JOB_FN = 0, JOB_DFT, JOB_DN, JOB_UQ, JOB_UKV, JOB_WO, JOB_GU, JOB_FD };
DI float prep_val(const Args& a, int job, int layer, int k, int n) {
    switch (job) {
    case JOB_FN: return a.fnet_w[(size_t)k * 1024 + n];
    case JOB_DFT: { const int ri = k >> 8, n2 = k & 255; const float fr = (float)((n2 * n) & 255) * (1.0f / 256); return ri ? sin2pi(fr) : cos2pi(fr); }
    case JOB_DN: return n < 576 ? a.norm_g[(4 + 0) * 1024 + k] * a.w_down[(size_t)k * 576 + n] : 0.f;
    case JOB_UQ: { const int hh = n / 192, c = n % 192; int sc = c; if (c >= 128) { const int p = c - 128; sc = 128 + 32 * ((p >> 2) & 1) + 4 * (p >> 3) + (p & 3); }
        return a.q_norm[k] * a.w_uq[(size_t)k * 1536 + hh * 192 + sc] * QSCALE; }
    case JOB_UKV: return a.kv_norm[k] * a.w_ukv[(size_t)k * 2048 + n];
    case JOB_WO: return a.w_o[(size_t)k * 1024 + n];
    case JOB_GU: { const int pn = n >> 8, isup = (n >> 7) & 1, col = pn * 128 + (n & 127); const float* w = (isup ? a.w_up : a.w_gate) + (size_t)layer * 1024 * DFF;
        return a.norm_g[(layer * 4 + 2) * 1024 + k] * w[(size_t)k * DFF + col]; }
    default: return a.w_fdown[(size_t)layer * DFF * 1024 + (size_t)k * 1024 + n];
    }
}
DI void prep_job(const Args& a, int job, int layer, int N, int K, bf16_t* dst, float* scr, int item0, int& item_base, int G, int bid, int wv) {
    const int tn = N / 64, tk = K / 64, n_items = tn * tk, tid = otid(wv);
    int first = item_base; item_base += n_items;
    int i = bid - (first % G); if (i < 0) i += G;
    for (; i < n_items; i += G) {
        const int n0 = (i % tn) * 64, k0 = (i / tn) * 64;
        __syncthreads();
#pragma unroll
        for (int e8 = 0; e8 < 8; ++e8) { const int e = tid + e8 * 512, kk = e >> 6, nn = e & 63; scr[nn * 65 + kk] = prep_val(a, job, layer, k0 + kk, n0 + nn); }
        __syncthreads();
#pragma unroll
        for (int e4 = 0; e4 < 4; ++e4) { const int e = tid + e4 * 512, nn = e >> 5, k2 = (e & 31) * 2;
            *(unsigned*)(dst + (size_t)(n0 + nn) * K + k0 + k2) = cvt_pk_bf16(scr[nn * 65 + k2], scr[nn * 65 + k2 + 1]); }
    }
    (void)item0;
}

DI void row_first(const Args& a, bf16_t* H, int G, int bid, int wv) {
    const int tid_ = otid(wv), wid = tid_ >> 6, lane = tid_ & 63;
    const float* g = a.norm_g;
    constexpr int NR = 4; const int rstep = G * 8;
    for (int row0 = bid * 8 + wid; row0 < T_ALL; row0 += rstep * NR) {
        f32x4 x[NR][4];
#pragma unroll
        for (int q = 0; q < NR; ++q) { const int row = min(row0 + q * rstep, T_ALL - 1);
            const float* xr = row < T_HALF ? a.xp + (size_t)row * 1024 : a.xs + (size_t)(row - T_HALF) * 1024;
#pragma unroll
            for (int hv = 0; hv < 2; ++hv) { x[q][2 * hv] = gld_f4(xr + hv * 512 + lane * 8); x[q][2 * hv + 1] = gld_f4(xr + hv * 512 + lane * 8 + 4); } }
#pragma unroll
        for (int q = 0; q < NR; ++q) { const int row = row0 + q * rstep; if (row >= T_ALL) continue;
            float ss = 0.f;
#pragma unroll
            for (int i = 0; i < 4; ++i)
#pragma unroll
                for (int j = 0; j < 4; ++j) ss += x[q][i][j] * x[q][i][j];
            ss = wave_sum(ss); const float r = rsqrtf(ss * (1.0f / 1024) + NORM_EPS);
#pragma unroll
            for (int hv = 0; hv < 2; ++hv) { const int c = hv * 512 + lane * 8; const f32x4 g0 = gld_f4(g + c), g1 = gld_f4(g + c + 4);
                const f32x4 y0 = x[q][2 * hv] * r * g0, y1 = x[q][2 * hv + 1] * r * g1;
                u32x4 w = {cvt_pk_bf16(y0[0], y0[1]), cvt_pk_bf16(y0[2], y0[3]), cvt_pk_bf16(y1[0], y1[1]), cvt_pk_bf16(y1[2], y1[3])};
                gst_u4(H + (size_t)row * 1024 + c, w); } }
    }
}
DI void row_mid(const bf16_t* m, const float* gpost, const float* xf0, const float* xf1, const bf16_t* xb_in, bf16_t* xb_out, float* rs_out, float* out_f, int G, int bid, int wv) {
    const int tid_ = otid(wv), wid = tid_ >> 6, lane = tid_ & 63;
    constexpr int NR = 2;
    const int rstep = G * 8, step = rstep * NR;
#define RM_LOAD(X, MW, R0) do { _Pragma("unroll") for (int q = 0; q < NR; ++q) { const int row = min((R0) + q * rstep, T_ALL - 1); \
        _Pragma("unroll") for (int hv = 0; hv < 2; ++hv) { const int c = hv * 512 + lane * 8; \
            if (xb_in) { const u32x4 w = gld_u4(xb_in + (size_t)row * 1024 + c); \
                X[q][2 * hv] = (f32x4){bf2f(w.x & 0xffff), bf2f(w.x >> 16), bf2f(w.y & 0xffff), bf2f(w.y >> 16)}; \
                X[q][2 * hv + 1] = (f32x4){bf2f(w.z & 0xffff), bf2f(w.z >> 16), bf2f(w.w & 0xffff), bf2f(w.w >> 16)}; } \
            else { const float* xr = row < T_HALF ? xf0 + (size_t)row * 1024 : xf1 + (size_t)(row - T_HALF) * 1024; \
                X[q][2 * hv] = gld_f4(xr + c); X[q][2 * hv + 1] = gld_f4(xr + c + 4); } \
            MW[q][hv] = gld_u4(m + (size_t)row * 1024 + c); } } } while (0)
#define RM_PROC(X, MW, R0) do { _Pragma("unroll") for (int q = 0; q < NR; ++q) { const int row = (R0) + q * rstep; if (row >= T_ALL) continue; \
        f32x4 mv[4]; float ss = 0.f; \
        _Pragma("unroll") for (int hv = 0; hv < 2; ++hv) { const u32x4 w = MW[q][hv]; \
            mv[2 * hv] = (f32x4){bf2f(w.x & 0xffff), bf2f(w.x >> 16), bf2f(w.y & 0xffff), bf2f(w.y >> 16)}; \
            mv[2 * hv + 1] = (f32x4){bf2f(w.z & 0xffff), bf2f(w.z >> 16), bf2f(w.w & 0xffff), bf2f(w.w >> 16)}; } \
        _Pragma("unroll") for (int i = 0; i < 4; ++i) _Pragma("unroll") for (int j = 0; j < 4; ++j) ss += mv[i][j] * mv[i][j]; \
        ss = wave_sum(ss); const float r1 = rsqrtf(ss * (1.0f / 1024) + NORM_EPS); \
        float s2 = 0.f; \
        _Pragma("unroll") for (int hv = 0; hv < 2; ++hv) { const int c = hv * 512 + lane * 8; const f32x4 g0 = gld_f4(gpost + c), g1 = gld_f4(gpost + c + 4); \
            X[q][2 * hv] = X[q][2 * hv] + mv[2 * hv] * r1 * g0; X[q][2 * hv + 1] = X[q][2 * hv + 1] + mv[2 * hv + 1] * r1 * g1; \
            if (out_f) { gst_f4(out_f + (size_t)row * 1024 + c, X[q][2 * hv]); gst_f4(out_f + (size_t)row * 1024 + c + 4, X[q][2 * hv + 1]); } \
            else { const f32x4 y0 = X[q][2 * hv], y1 = X[q][2 * hv + 1]; \
                u32x4 w = {cvt_pk_bf16(y0[0], y0[1]), cvt_pk_bf16(y0[2], y0[3]), cvt_pk_bf16(y1[0], y1[1]), cvt_pk_bf16(y1[2], y1[3])}; \
                gst_u4(xb_out + (size_t)row * 1024 + c, w); } } \
        if (rs_out) { \
            _Pragma("unroll") for (int i = 0; i < 4; ++i) _Pragma("unroll") for (int j = 0; j < 4; ++j) s2 += X[q][i][j] * X[q][i][j]; \
            s2 = wave_sum(s2); if (lane == 0) rs_out[row] = rsqrtf(s2 * (1.0f / 1024) + NORM_EPS); } } } while (0)
    f32x4 xa[NR][4], xb2[NR][4]; u32x4 ma[NR][2], mb[NR][2];
    int row0 = bid * 8 + wid;
    if (row0 < T_ALL) RM_LOAD(xa, ma, row0);
    while (row0 < T_ALL) {
        const int rowB = row0 + step; const bool hb = rowB < T_ALL;
        if (hb) RM_LOAD(xb2, mb, rowB);
        RM_PROC(xa, ma, row0);
        if (!hb) break;
        const int rowA = rowB + step; const bool ha = rowA < T_ALL;
        if (ha) RM_LOAD(xa, ma, rowA);
        RM_PROC(xb2, mb, rowB);
        if (!ha) break;
        row0 = rowA;
    }
#undef RM_LOAD
#undef RM_PROC
}
DI void row_mla(const bf16_t* down, const float* rope, bf16_t* cq, bf16_t* ckv, bf16_t* kr, int G, int bid, int wv) {
    const int tid_ = otid(wv), wid = tid_ >> 6, lane = tid_ & 63;
    constexpr int NR = 4;
    const int rstep = G * 8, i = lane & 31;
    for (int row0 = bid * 8 + wid; row0 < T_ALL; row0 += rstep * NR) {
        u32x2 av[NR], bv[NR]; unsigned short kv[NR]; float csv[NR], snv[NR];
#pragma unroll
        for (int q = 0; q < NR; ++q) { const int row = min(row0 + q * rstep, T_ALL - 1); const bf16_t* dr = down + (size_t)row * 768;
            av[q] = *(const GAS u32x2*)(dr + lane * 4); bv[q] = *(const GAS u32x2*)(dr + 256 + lane * 4); kv[q] = *(const GAS unsigned short*)(dr + 512 + lane);
            const int pos = row < T_HALF ? (row & (S_P - 1)) : (row & (S_S - 1));
            const float* rp = rope + ((size_t)pos * 32 + i) * 2; csv[q] = *(const GAS float*)rp; snv[q] = *(const GAS float*)(rp + 1); }
#pragma unroll
        for (int q = 0; q < NR; ++q) { const int row = row0 + q * rstep; if (row >= T_ALL) continue;
            const u32x2 a = av[q], b = bv[q];
            const float a0 = bf2f(a.x & 0xffff), a1 = bf2f(a.x >> 16), a2 = bf2f(a.y & 0xffff), a3 = bf2f(a.y >> 16);
            const float b0 = bf2f(b.x & 0xffff), b1 = bf2f(b.x >> 16), b2 = bf2f(b.y & 0xffff), b3 = bf2f(b.y >> 16);
            const float sa = wave_sum(a0 * a0 + a1 * a1 + a2 * a2 + a3 * a3), sb = wave_sum(b0 * b0 + b1 * b1 + b2 * b2 + b3 * b3);
            const float ra = rsqrtf(sa * (1.0f / 256) + NORM_EPS), rb = rsqrtf(sb * (1.0f / 256) + NORM_EPS);
            u32x2 wa = {cvt_pk_bf16(a0 * ra, a1 * ra), cvt_pk_bf16(a2 * ra, a3 * ra)}, wb = {cvt_pk_bf16(b0 * rb, b1 * rb), cvt_pk_bf16(b2 * rb, b3 * rb)};
            gst_u2(cq + (size_t)row * 256 + lane * 4, wa); gst_u2(ckv + (size_t)row * 256 + lane * 4, wb);
            const float xv = bf2f(kv[q]); const float xo = __shfl_xor(xv, 32);
            const float cs = csv[q], sn = snv[q];
            const float ov = lane < 32 ? (xv * cs - xo * sn) : (xv * cs + xo * sn);
            const int pidx = 8 * (i >> 2) + 4 * (lane >> 5) + (i & 3);
            gst_h(kr + (size_t)row * 64 + pidx, f2bf(ov)); }
    }
}


#define XB_TMO      128
#define XB_XCNT(j)  (256  + 64 * (j))
#define XB_XSUB(j)  (1280 + 64 * (j))
#define XB_XGEN(j)  (2304 + 64 * (j))
#define XB_TOP      3328
#define XB_TOPGEN   3392
#define XB_SPIN_CAP (1u << 22)
DI unsigned xb_ld(unsigned* p)              { return __hip_atomic_load(p, __ATOMIC_RELAXED, __HIP_MEMORY_SCOPE_AGENT); }
DI unsigned xb_add(unsigned* p, unsigned v) { return __hip_atomic_fetch_add(p, v, __ATOMIC_RELAXED, __HIP_MEMORY_SCOPE_AGENT); }
DI unsigned xb_xcc_id() { return (unsigned)__builtin_amdgcn_s_getreg((3 << 11) | 20) & 0xFu; }
#define XB_SPIN(cond, bar) do { unsigned _sp = 0; while (cond) { __builtin_amdgcn_s_sleep(1); \
    if ((++_sp & 255u) == 0u) { if (xb_ld(&(bar)[XB_TMO])) break; if (_sp > XB_SPIN_CAP) { atomicAdd(&(bar)[XB_TMO], 1u); break; } } } } while (0)
struct XcdBarrier { unsigned* bar; unsigned x; volatile LAS unsigned* st; };
DI void xcd_barrier_complete(unsigned* bar, unsigned x, unsigned& nloc, unsigned& nx) {
    const unsigned G = gridDim.x;
    unsigned sum, cnt, mine, sp = 0u;
    for (;;) {
        sum = 0u; cnt = 0u; mine = 0u;
#pragma unroll
        for (unsigned j = 0; j < 16; ++j) { const unsigned c = xb_ld(&bar[XB_XCNT(j)]); sum += c; cnt += (c > 0u) ? 1u : 0u; mine = (j == x) ? c : mine; }
        if (sum == G) break;
        __builtin_amdgcn_s_sleep(1);
        if ((++sp & 255u) == 0u) { if (xb_ld(&bar[XB_TMO])) break; if (sp > XB_SPIN_CAP) { atomicAdd(&bar[XB_TMO], 1u); break; } }
    }
    nloc = mine > 0u ? mine : 1u; nx = cnt > 0u ? cnt : 1u;
}
DI void xcd_barrier(const XcdBarrier& b, int wv) {
    asm volatile("s_waitcnt vmcnt(0)" ::: "memory");
    __syncthreads();
    if (otid(wv) == 0) {
        unsigned* bar = b.bar;
        __builtin_amdgcn_s_waitcnt(0);
        unsigned nloc = b.st[0], nx = b.st[1];
        if (nloc == 0u) { xcd_barrier_complete(bar, b.x, nloc, nx); b.st[0] = nloc; b.st[1] = nx; }
        const unsigned old = xb_add(&bar[XB_XSUB(b.x)], 1u);
        const unsigned gen = old / nloc;
        if (old + 1u == (gen + 1u) * nloc) {
            __builtin_amdgcn_fence(__ATOMIC_RELEASE, "agent");
            asm volatile("s_waitcnt vmcnt(0)" ::: "memory");
            const unsigned og = xb_add(&bar[XB_TOP], 1u);
            const unsigned tg = og / nx;
            if (og + 1u == (tg + 1u) * nx) xb_add(&bar[XB_TOPGEN], 1u);
            else XB_SPIN(xb_ld(&bar[XB_TOPGEN]) == tg, bar);
            __builtin_amdgcn_fence(__ATOMIC_ACQUIRE, "agent");
            xb_add(&bar[XB_XGEN(b.x)], 1u);
            asm volatile("s_waitcnt vmcnt(0)" ::: "memory");
        } else {
            XB_SPIN(xb_ld(&bar[XB_XGEN(b.x)]) == gen, bar);
            __builtin_amdgcn_fence(__ATOMIC_ACQUIRE, "agent");
            asm volatile("s_waitcnt vmcnt(0)" ::: "memory");
        }
    }
    __syncthreads();
}

constexpr int LDS_BYTES = 147456;
constexpr int LDS_BAR_OFF = LDS_BYTES - 64;
constexpr int NPHASE = 27;

DI unsigned char* opq(unsigned char* p) { asm volatile("" : "+s"(p)); return (unsigned char*)(__attribute__((address_space(1))) unsigned char*)p; }
__global__ void __launch_bounds__(512, 2) mega(Args a) {
    extern __shared__ __attribute__((aligned(16))) unsigned char lds[];
    cg::grid_group grid = cg::this_grid();
    const int G = gridDim.x, bid = blockIdx.x, wv = __builtin_amdgcn_readfirstlane((int)threadIdx.x >> 6);
    const int lo = a.ph_lo, hi = a.ph_hi;
#ifndef PHMASK
#define PHMASK 0xFFFFFFFFu
#endif
#define IN(k) ((((PHMASK) >> (k)) & 1u) && lo <= (k) && (k) < hi)
    XcdBarrier xbar; xbar.bar = (unsigned*)a.ws; xbar.x = xb_xcc_id(); xbar.st = (volatile LAS unsigned*)((LAS unsigned char*)lds + LDS_BAR_OFF);
    if (threadIdx.x < 2) xbar.st[threadIdx.x] = 0u;
    if (threadIdx.x == 0) (void)xb_add(&xbar.bar[XB_XCNT(xbar.x)], 1u);
    __syncthreads();
    if (lo < 0) grid.sync();
#define SYNC(k) do { if (lo <= (k) && (k) + 1 < hi) xcd_barrier(xbar, wv); } while (0)
#define WSB(off) ((bf16_t*)(opq(a.ws) + (off)))
#define LDSL ((LAS unsigned char*)lds)
#ifndef NREP
#define NREP 1
#endif
#define REP for (int rep_ = 0; rep_ < NREP; ++rep_)

    if (IN(0)) REP {
        int ib = 0; float* scr = (float*)lds;
        prep_job(a, JOB_FN, 0, 1024, 1024, WSB(WS_WFN), scr, 0, ib, G, bid, wv);
        prep_job(a, JOB_DFT, 0, 256, 512, WSB(WS_DFT), scr, 0, ib, G, bid, wv);
        prep_job(a, JOB_DN, 0, 768, 1024, WSB(WS_WDN), scr, 0, ib, G, bid, wv);
        prep_job(a, JOB_UQ, 0, 1536, 256, WSB(WS_WUQ), scr, 0, ib, G, bid, wv);
        prep_job(a, JOB_UKV, 0, 2048, 256, WSB(WS_WUKV), scr, 0, ib, G, bid, wv);
        prep_job(a, JOB_WO, 0, 1024, 1024, WSB(WS_WO), scr, 0, ib, G, bid, wv);
        prep_job(a, JOB_GU, 0, 5632, 1024, WSB(WS_WGU), scr, 0, ib, G, bid, wv);
        prep_job(a, JOB_FD, 0, 1024, 2816, WSB(WS_WFD), scr, 0, ib, G, bid, wv);
        float* rope = (float*)WSB(WS_ROPE);
        for (int e = bid * 512 + otid(wv); e < 16384 * 32; e += G * 512) { const int pos = e >> 5, i = e & 31;
            const float inv = 1.0f / powf(10000.0f, (float)(2 * i) / 64.0f); const float ang = (float)pos * inv;
            const double rev = (double)ang * 0.15915494309189535; const float fr = (float)(rev - floor(rev));
            rope[(size_t)e * 2] = cos2pi(fr); rope[(size_t)e * 2 + 1] = sin2pi(fr); }
        row_first(a, WSB(WS_H), G, bid, wv);
    }
    SYNC(0);
    if (IN(1)) REP fft::fft_phase<128, 1>((char*)lds, WSB(WS_H), WSB(WS_TP), 2, G, bid, wv);
    SYNC(1);
    if (IN(2)) REP fft::fft_phase<128, 2>((char*)lds, WSB(WS_TP), WSB(WS_PQ), 2, G, bid, wv);
    SYNC(2);
    if (IN(3)) REP { pg8::Gemm g{WSB(WS_PQ), WSB(WS_DFT), T_HALF, 1024, 512, 2048, 1024, 1, 0}; pg8::StaticOrder S; S.init(T_HALF, 1024, G, bid);
        pg8::EpiStore E{WSB(WS_H), 1024, nullptr, nullptr}; pg8::gemm_phase(LDSL, g, S, E, wv); }
    if (IN(4)) REP fft::fft_phase<64, 1>((char*)lds, WSB(WS_H) + (size_t)T_HALF * 1024, WSB(WS_TP), 8, G, bid, wv);
    SYNC(4);
    if (IN(5)) REP fft::fft_phase<64, 2>((char*)lds, WSB(WS_TP), WSB(WS_PQ), 8, G, bid, wv);
    SYNC(5);
    if (IN(6)) REP { pg8::Gemm g{WSB(WS_PQ), WSB(WS_DFT), T_HALF, 1024, 512, 2048, 1024, 1, 0}; pg8::StaticOrder S; S.init(T_HALF, 1024, G, bid);
        pg8::EpiStore E{WSB(WS_H) + (size_t)T_HALF * 1024, 1024, nullptr, nullptr}; pg8::gemm_phase(LDSL, g, S, E, wv); }
    SYNC(6);
    if (IN(7)) REP { pg8::Gemm g{WSB(WS_H), WSB(WS_WFN), T_ALL, 1024, 1024, 1024, 0, 0, 0}; pg8::StaticOrder S; S.init(T_ALL, 1024, G, bid);
        pg8::EpiStore E{WSB(WS_M), 1024, a.fnet_b, nullptr}; pg8::gemm_phase(LDSL, g, S, E, wv); }
    SYNC(7);
    if (IN(8)) REP row_mid(WSB(WS_M), a.norm_g + 1 * 1024, a.xp, a.xs, nullptr, (bf16_t*)a.out, (float*)WSB(WS_RSTD), nullptr, G, bid, wv);
    SYNC(8);
#define FFN_PHASES(base, layer, last) \
    for (int hf = 0; hf < 2; ++hf) { \
        if (IN((base) + 2 * hf)) REP { const bf16_t* xres = (layer) ? (const bf16_t*)WSB(WS_H) : (const bf16_t*)a.out;     \
            pg8::Gemm g{xres + (size_t)hf * T_HALF * 1024, WSB(WS_WGU), T_HALF, 5632, 1024, 1024, 0, 0, 0}; pg8::StaticOrder S; S.init(T_HALF, 5632, G, bid); \
            pg8::EpiSwiGLU E{WSB(WS_ACT), (const float*)WSB(WS_RSTD) + (size_t)hf * T_HALF}; pg8::gemm_phase(LDSL, g, S, E, wv); } \
        SYNC((base) + 2 * hf); \
        if (IN((base) + 2 * hf + 1)) REP { pg8::Gemm g{WSB(WS_ACT), WSB(WS_WFD), T_HALF, 1024, DFF, DFF, 0, 0, 0}; pg8::StaticOrder S; S.init(T_HALF, 1024, G, bid); \
            pg8::EpiStore E{WSB(WS_F) + (size_t)hf * T_HALF * 1024, 1024, nullptr, nullptr}; pg8::gemm_phase(LDSL, g, S, E, wv); } \
        SYNC((base) + 2 * hf + 1); \
    } \
    if (IN((base) + 4)) { if (last) row_mid(WSB(WS_F), a.norm_g + ((layer) * 4 + 3) * 1024, nullptr, nullptr, WSB(WS_H), nullptr, nullptr, a.out, G, bid, wv); \
                          else row_mid(WSB(WS_F), a.norm_g + ((layer) * 4 + 3) * 1024, nullptr, nullptr, (const bf16_t*)a.out, (bf16_t*)a.out, (float*)WSB(WS_RSTD), nullptr, G, bid, wv); } \
    SYNC((base) + 4);
#pragma unroll 1
    for (int layer = 0; layer < 2; ++layer) {
        const int base = layer ? 22 : 9;
        if (layer == 1) {
            if (IN(14)) REP { pg8::Gemm g{(const bf16_t*)a.out, WSB(WS_WDN), T_ALL, 768, 1024, 1024, 0, 0, 0}; pg8::StaticOrder S; S.init(T_ALL, 768, G, bid);
                pg8::EpiStore E{WSB(WS_DOWN), 768, nullptr, (const float*)WSB(WS_RSTD)}; pg8::gemm_phase(LDSL, g, S, E, wv); }
            SYNC(14);
            if (IN(15)) REP {
                row_mla(WSB(WS_DOWN), (const float*)WSB(WS_ROPE), WSB(WS_CQ), WSB(WS_CKV), WSB(WS_KR), G, bid, wv);
                int ib = 0; float* scr = (float*)lds;
                prep_job(a, JOB_GU, 1, 5632, 1024, WSB(WS_WGU), scr, 0, ib, G, bid, wv);
                prep_job(a, JOB_FD, 1, 1024, 2816, WSB(WS_WFD), scr, 0, ib, G, bid, wv);
                __syncthreads();
            }
            SYNC(15);
            if (IN(16)) REP { pg8::Gemm g{WSB(WS_CQ), WSB(WS_WUQ), T_ALL, 1536, 256, 256, 0, 0, 0}; pg8::StaticOrder S; S.init(T_ALL, 1536, G, bid);
                pg8::EpiStore E{WSB(WS_Q), 1536, nullptr, nullptr}; pg8::gemm_phase(LDSL, g, S, E, wv); }
#define KN_OF(hf) ((hf) ? (bf16_t*)((unsigned char*)a.out + 128 * MiB) : WSB(WS_KN))
#define V_OF(hf)  ((hf) ? (bf16_t*)((unsigned char*)a.out + 192 * MiB) : WSB(WS_V))
#pragma unroll 1
            for (int hf = 0; hf < 2; ++hf) {
                if (IN(16)) REP { pg8::Gemm g{WSB(WS_CKV) + (size_t)hf * T_HALF * 256, WSB(WS_WUKV), T_HALF, 2048, 256, 256, 0, 0, 0}; pg8::StaticOrder S; S.init(T_HALF, 2048, G, bid);
                    pg8::EpiKV E{KN_OF(hf), V_OF(hf)}; pg8::gemm_phase(LDSL, g, S, E, wv); }
            }
            SYNC(16);
            if (IN(17)) {
#pragma unroll 1
                for (int hf = 0; hf < 2; ++hf) {
                    const int xcd = bid & 7, slot = bid >> 3;
                    for (int it = 0; it * G < 1024; ++it) {
                        int combo, qb;
                        if (G == 256) { if (hf == 0) { combo = it * 4 + (xcd >> 1); qb = (xcd & 1) * 32 + slot; } else { combo = it * 16 + xcd * 2 + (slot >> 4); qb = slot & 15; } }
                        else { const int u = it * G + bid; if (u >= 1024) break; if (hf == 0) { combo = u >> 6; qb = u & 63; } else { combo = u >> 4; qb = u & 15; } }
                        const int bt = combo >> 3, hh = combo & 7; const int seq = hf ? S_S : S_P;
                        const size_t tloc = (size_t)bt * seq, tglob = (size_t)hf * T_HALF + tloc;
                        bf16_t* qp = WSB(WS_Q) + (tglob + (size_t)qb * 256) * 1536 + hh * 192;
                        att::attn_unit(qp, KN_OF(hf) + tloc * 1024 + hh * 128, WSB(WS_KR) + tglob * 64, V_OF(hf) + tloc * 1024 + hh * 128, qp, seq, (char*)lds, wv, (const float*)WSB(WS_ROPE), qb * 256);
                    }
                }
            }
            SYNC(17);
#undef KN_OF
#undef V_OF
            if (IN(20)) REP { pg8::Gemm g{WSB(WS_Q), WSB(WS_WO), T_ALL, 1024, 1024, 1536, 0, 0, 1}; pg8::StaticOrder S; S.init(T_ALL, 1024, G, bid);
                pg8::EpiStore E{WSB(WS_M2), 1024, nullptr, nullptr}; pg8::gemm_phase(LDSL, g, S, E, wv); }
            SYNC(20);
            if (IN(21)) row_mid(WSB(WS_M2), a.norm_g + (4 + 1) * 1024, nullptr, nullptr, (const bf16_t*)a.out, WSB(WS_H), (float*)WSB(WS_RSTD), nullptr, G, bid, wv);
            SYNC(21);
        }
        FFN_PHASES(base, layer, layer == 1)
    }
#ifdef DBG_OFF
    if (hi >= 27) { grid.sync(); const bf16_t* sp = WSB(DBG_OFF);
        for (size_t i = (size_t)bid * 512 + otid(wv); i < (size_t)T_ALL * 1024; i += (size_t)G * 512) a.out[i] = bf2f(sp[i]); }
#endif
#undef IN
#undef SYNC
}

extern "C" void kernel_launch(void* const* d_in, const int* in_sizes, int n_in, void* d_out, int out_size, void* d_ws, size_t ws_size, hipStream_t stream) {
    static int grid = 0;
    if (grid == 0) {
        if (n_in != 14 || out_size != T_ALL * DM || ws_size < WS_END) { fprintf(stderr, "kernel_launch: unexpected shapes (n_in %d out %d ws %zu)\n", n_in, out_size, ws_size); grid = -1; return; }
        int dev = 0, cus = 0, per_cu = 0;
        (void)hipGetDevice(&dev); (void)hipDeviceGetAttribute(&cus, hipDeviceAttributeMultiprocessorCount, dev);
        if (hipFuncSetAttribute((const void*)mega, hipFuncAttributeMaxDynamicSharedMemorySize, LDS_BYTES) != hipSuccess) { fprintf(stderr, "kernel_launch: hipFuncSetAttribute failed\n"); grid = -1; return; }
        (void)hipOccupancyMaxActiveBlocksPerMultiprocessor(&per_cu, (const void*)mega, 512, LDS_BYTES);
        (void)hipGetLastError();
        if (per_cu < 1) per_cu = 1;
        grid = cus * 1;
    }
    if (grid < 0) return;
    Args a{};
    a.xp = (const float*)d_in[0]; a.xs = (const float*)d_in[1]; a.norm_g = (const float*)d_in[2]; a.fnet_w = (const float*)d_in[3]; a.fnet_b = (const float*)d_in[4];
    a.w_down = (const float*)d_in[5]; a.q_norm = (const float*)d_in[6]; a.w_uq = (const float*)d_in[7]; a.kv_norm = (const float*)d_in[8]; a.w_ukv = (const float*)d_in[9];
    a.w_o = (const float*)d_in[10]; a.w_gate = (const float*)d_in[11]; a.w_up = (const float*)d_in[12]; a.w_fdown = (const float*)d_in[13];
    a.out = (float*)d_out; a.ws = (unsigned char*)d_ws; a.ph_lo = 0; a.ph_hi = NPHASE;
    if (hipMemsetAsync(d_ws, 0, 16384, stream) != hipSuccess) { fprintf(stderr, "kernel_launch: memset failed\n"); return; }
    void* args[] = {&a};
    hipError_t e = hipLaunchCooperativeKernel((const void*)mega, dim3(grid), dim3(512), args, LDS_BYTES, stream);
    if (e != hipSuccess) fprintf(stderr, "cooperative launch failed: %s (grid %d)\n", hipGetErrorString(e), grid);
}
```

```cpp
#include <hip/hip_runtime.h>
#include <hip/hip_cooperative_groups.h>
#include <cstdint>
#include <cstdio>
namespace cg = cooperative_groups;

#define DI __device__ __forceinline__
#define LAS __attribute__((address_space(3)))
typedef unsigned short bf16_t;
typedef short bf16x8 __attribute__((ext_vector_type(8)));
typedef short s16x4 __attribute__((ext_vector_type(4)));
typedef float f32x4 __attribute__((ext_vector_type(4)));
typedef float f32x16 __attribute__((ext_vector_type(16)));
typedef unsigned u32x4 __attribute__((ext_vector_type(4)));
typedef unsigned u32x2 __attribute__((ext_vector_type(2)));

constexpr int T_ALL = 65536, T_HALF = 32768, DM = 1024, DFF = 2816;
constexpr int S_P = 16384, S_S = 4096;
constexpr float NORM_EPS = 1e-6f;
constexpr float QSCALE = 0.07216878364870322f * 1.4426950408889634f;

constexpr size_t MiB = 1u << 20;
constexpr size_t WS_ROPE = 1 * MiB;
constexpr size_t WS_WFN  = 5 * MiB;
constexpr size_t WS_DFT  = 7 * MiB;
constexpr size_t WS_WDN  = 7 * MiB + 512 * 1024;
constexpr size_t WS_WUQ  = 9 * MiB;
constexpr size_t WS_WUKV = 10 * MiB;
constexpr size_t WS_WO   = 11 * MiB;
constexpr size_t WS_WGU  = 14 * MiB;
constexpr size_t WS_WFD  = 25 * MiB;
constexpr size_t WS_RSTD = 31 * MiB;
constexpr size_t WS_H    = 32 * MiB;
constexpr size_t WS_G    = 160 * MiB;
constexpr size_t WS_TP   = WS_G;
constexpr size_t WS_PQ   = WS_G + 128 * MiB;
constexpr size_t WS_M    = WS_G;
constexpr size_t WS_ACT  = WS_G;
constexpr size_t WS_F    = WS_G + 176 * MiB;
constexpr size_t WS_DOWN = WS_G;
constexpr size_t WS_CQ   = WS_G + 96 * MiB;
constexpr size_t WS_CKV  = WS_G + 128 * MiB;
constexpr size_t WS_KR   = WS_G + 160 * MiB;
constexpr size_t WS_Q    = 32 * MiB;
constexpr size_t WS_KN   = WS_G + 176 * MiB;
constexpr size_t WS_V    = WS_G + 240 * MiB;
constexpr size_t WS_M2   = WS_G + 176 * MiB;
constexpr size_t WS_END  = 464 * MiB;

DI int otid(int wv) { int l; asm volatile("v_mbcnt_lo_u32_b32 %0, -1, 0\n\tv_mbcnt_hi_u32_b32 %0, -1, %0" : "=v"(l)); return wv * 64 + l; }
typedef float f32x2_t __attribute__((ext_vector_type(2)));
typedef __bf16 bf16x2_t __attribute__((ext_vector_type(2)));
DI unsigned cvt_pk_bf16(float lo, float hi) { const f32x2_t v = {lo, hi}; const bf16x2_t b = __builtin_convertvector(v, bf16x2_t); return __builtin_bit_cast(unsigned, b); }
DI bf16_t f2bf(float x) { return (bf16_t)(cvt_pk_bf16(x, x) & 0xffffu); }
DI float bf2f(unsigned b) { return __uint_as_float(b << 16); }
DI float wave_sum(float v) {
#pragma unroll
    for (int o = 1; o < 64; o <<= 1) v += __shfl_xor(v, o);
    return v;
}
#define GAS __attribute__((address_space(1)))
DI bf16x8 gld_bf8(const void* p) { return *(const GAS bf16x8*)p; }
DI u32x4 gld_u4(const void* p) { return *(const GAS u32x4*)p; }
DI f32x4 gld_f4(const void* p) { return *(const GAS f32x4*)p; }
DI void gst_u4(void* p, u32x4 v) { *(GAS u32x4*)p = v; }
DI void gst_u2(void* p, u32x2 v) { *(GAS u32x2*)p = v; }
DI void gst_f4(void* p, f32x4 v) { *(GAS f32x4*)p = v; }
DI void gst_h(void* p, bf16_t v) { *(GAS bf16_t*)p = v; }
DI float cos2pi(float frac) { return __builtin_amdgcn_cosf(frac); }
DI float sin2pi(float frac) { return __builtin_amdgcn_sinf(frac); }

namespace pg8 {
constexpr int BM = 256, BK = 64, HALF = 128, HTB = HALF * BK * 2, STAGE_BYTES = 8 * HTB, NXCD = 8, WGM = 8;
DI int lds_byte(int r, int c) { const int st = (r >> 4) * 2 + (c >> 5), rr = r & 15, cc = c & 31, ob = rr * 64 + cc * 2; return st * 1024 + (ob ^ (((ob >> 9) & 1) << 5)); }
DI void stage_rc(int b, int& R, int& C) { const int st = b / 1024, sb = b % 1024, swz = sb ^ (((sb >> 9) & 1) << 5); R = (st >> 1) * 16 + swz / 64; C = (st & 1) * 32 + (swz % 64) / 2; }
DI int perm32(int rho) { const int n = rho >> 4, i = rho & 15; return 8 * (i >> 2) + 4 * n + (i & 3); }

struct Unit { int pm, pn; };
struct Gemm { const bf16_t* A; const bf16_t* Bt; int M, N, K, lda; long a_pn_off; int b_shared; int askip; };

struct StaticOrder {
    int nM, nN, nwg, G, c;
    DI void init(int M, int N, int G_, int c_) { nM = M / BM; nN = N / BM; nwg = nM * nN; G = G_; c = c_; }
    DI bool next(int i, Unit& u) const {
        const long L = (long)i * G + c; if (L >= nwg) return false;
        int wgid = (int)L; { const int q = nwg / NXCD, r = nwg % NXCD, xcd = wgid % NXCD, off = wgid / NXCD; wgid = (xcd < r ? xcd * (q + 1) : r * (q + 1) + (xcd - r) * q) + off; }
        const int nig = WGM * nN, gid = wgid / nig, fm = gid * WGM, gsz = (nM - fm) < WGM ? (nM - fm) : WGM;
        u.pm = fm + ((wgid % nig) % gsz); u.pn = (wgid % nig) / gsz; return true;
    }
};

struct EpiStore {
    bf16_t* O; int ldc; const float* bias; const float* rs;
    DI void operator()(const f32x4 (&acc)[2][2][4][2], const Unit& u, int wr, int wc, int fr, int fq) const {
        const int row0 = u.pm * BM + wr * 64 + fr; const int col0 = u.pn * BM + wc * 32 + 8 * fq;
        f32x4 bv[2][2];
#pragma unroll
        for (int bj = 0; bj < 2; ++bj)
#pragma unroll
            for (int n = 0; n < 2; ++n) bv[bj][n] = bias ? *(const f32x4*)(bias + col0 + bj * HALF + 4 * n) : (f32x4){0.f, 0.f, 0.f, 0.f};
#pragma unroll
        for (int ai = 0; ai < 2; ++ai)
#pragma unroll
            for (int m = 0; m < 4; ++m) { const int row = row0 + ai * HALF + m * 16; bf16_t* rowp = O + (size_t)row * ldc + col0;
                const float sc = rs ? rs[row] : 1.f;
#pragma unroll
                for (int bj = 0; bj < 2; ++bj) { f32x4 v0 = (acc[ai][bj][m][0] + bv[bj][0]) * sc, v1 = (acc[ai][bj][m][1] + bv[bj][1]) * sc;
                    u32x4 w; w.x = cvt_pk_bf16(v0[0], v0[1]); w.y = cvt_pk_bf16(v0[2], v0[3]); w.z = cvt_pk_bf16(v1[0], v1[1]); w.w = cvt_pk_bf16(v1[2], v1[3]);
                    *(u32x4*)(rowp + bj * HALF) = w; } }
    }
};
DI float silu_mul(float g, float u) { return g * __builtin_amdgcn_rcpf(1.f + __builtin_amdgcn_exp2f(-1.4426950408889634f * g)) * u; }
struct EpiSwiGLU {
    bf16_t* O; const float* rs;
    DI void operator()(const f32x4 (&acc)[2][2][4][2], const Unit& u, int wr, int wc, int fr, int fq) const {
        const int row0 = u.pm * BM + wr * 64 + fr; const int col0 = u.pn * HALF + wc * 32 + 8 * fq;
#pragma unroll
        for (int ai = 0; ai < 2; ++ai)
#pragma unroll
            for (int m = 0; m < 4; ++m) { const int row = row0 + ai * HALF + m * 16; bf16_t* rowp = O + (size_t)row * DFF + col0; const float sc = rs[row];
                const f32x4 g0 = acc[ai][0][m][0] * sc, g1 = acc[ai][0][m][1] * sc, u0 = acc[ai][1][m][0] * sc, u1 = acc[ai][1][m][1] * sc;
                u32x4 w; w.x = cvt_pk_bf16(silu_mul(g0[0], u0[0]), silu_mul(g0[1], u0[1])); w.y = cvt_pk_bf16(silu_mul(g0[2], u0[2]), silu_mul(g0[3], u0[3]));
                w.z = cvt_pk_bf16(silu_mul(g1[0], u1[0]), silu_mul(g1[1], u1[1])); w.w = cvt_pk_bf16(silu_mul(g1[2], u1[2]), silu_mul(g1[3], u1[3]));
                *(u32x4*)rowp = w; }
    }
};
struct EpiQ {
    bf16_t* O; const float* rope;
    DI void operator()(const f32x4 (&acc)[2][2][4][2], const Unit& u, int wr, int wc, int fr, int fq) const {
        const int row0 = u.pm * BM + wr * 64 + fr;
#pragma unroll
        for (int ai = 0; ai < 2; ++ai)
#pragma unroll
            for (int m = 0; m < 4; ++m) { const int row = row0 + ai * HALF + m * 16; const int pos = row < T_HALF ? (row & (S_P - 1)) : (row & (S_S - 1));
#pragma unroll
                for (int bj = 0; bj < 2; ++bj) { const int cb32 = u.pn * BM + bj * HALF + wc * 32, c0 = cb32 + 8 * fq; const int hcb = cb32 % 192;
                    f32x4 v0 = acc[ai][bj][m][0], v1 = acc[ai][bj][m][1];
                    if (hcb >= 128) { const int t = ((hcb - 128) >> 3) + fq; const float* cs = rope + ((size_t)pos * 32 + 4 * t) * 2;
                        const f32x4 a = *(const f32x4*)cs, b = *(const f32x4*)(cs + 4);
                        const f32x4 cv = {a[0], a[2], b[0], b[2]}, sv = {a[1], a[3], b[1], b[3]};
                        const f32x4 o1 = v0 * cv - v1 * sv, o2 = v1 * cv + v0 * sv; v0 = o1; v1 = o2; }
                    u32x4 w; w.x = cvt_pk_bf16(v0[0], v0[1]); w.y = cvt_pk_bf16(v0[2], v0[3]); w.z = cvt_pk_bf16(v1[0], v1[1]); w.w = cvt_pk_bf16(v1[2], v1[3]);
                    *(u32x4*)(O + (size_t)row * 1536 + c0) = w; }
                __builtin_amdgcn_sched_barrier(0); }
    }
};
struct EpiKV {
    bf16_t* Kn; bf16_t* V; bf16_t* Kn1; bf16_t* V1;
    DI void operator()(const f32x4 (&acc)[2][2][4][2], const Unit& u, int wr, int wc, int fr, int fq) const {
        const bool g1 = u.pm >= T_HALF / BM;
        bf16_t* kd = g1 ? Kn1 : Kn; bf16_t* vd = g1 ? V1 : V;
        const int row0 = (u.pm - (g1 ? T_HALF / BM : 0)) * BM + wr * 64 + fr; const int col0 = u.pn * HALF + wc * 32 + 8 * fq;
#pragma unroll
        for (int ai = 0; ai < 2; ++ai)
#pragma unroll
            for (int m = 0; m < 4; ++m) { const size_t off = (size_t)(row0 + ai * HALF + m * 16) * 1024 + col0;
#pragma unroll
                for (int bj = 0; bj < 2; ++bj) { const f32x4 v0 = acc[ai][bj][m][0], v1 = acc[ai][bj][m][1];
                    u32x4 w; w.x = cvt_pk_bf16(v0[0], v0[1]); w.y = cvt_pk_bf16(v0[2], v0[3]); w.z = cvt_pk_bf16(v1[0], v1[1]); w.w = cvt_pk_bf16(v1[2], v1[3]);
                    *(u32x4*)((bj ? vd : kd) + off) = w; } }
    }
};

template <class Epi>
DI void gemm_phase(LAS unsigned char* lds, const Gemm g, const StaticOrder& S, const Epi& E, int wv) {
    const int tid = otid(wv), wid = __builtin_amdgcn_readfirstlane(tid >> 6), lane = tid & 63, wr = wid >> 2, wc = wid & 3, fr = lane & 15, fq = lane >> 4;
    int K = g.K; asm volatile("" : "+s"(K));
    const int nt = K / BK;
    unsigned voffA[2], voffB[2];
#pragma unroll
    for (int i = 0; i < 2; ++i) { int R, C; stage_rc(tid * 16 + i * 8192, R, C); const int Rb = (R & ~31) + perm32(R & 31);
        voffA[i] = (unsigned)(R * g.lda + C) * 2u; voffB[i] = (unsigned)(Rb * K + C) * 2u; }
    const size_t kstep = (size_t)(BK * 2);
    const size_t hA = (size_t)HALF * g.lda * 2, tA = 2 * hA;
    const size_t hB = (size_t)HALF * K * 2, tB = g.b_shared ? 0 : 2 * hB;
    const unsigned ldsw = (unsigned)wid * 1024u;
    const int aoff = lds_byte(wr * 64 + fr, fq * 8), boff = lds_byte(wc * 32 + fr, fq * 8);
#define PG8_SA(b, h) (((b) * 2 + (h)) * HTB)
#define PG8_SB(b, h) ((4 + (b) * 2 + (h)) * HTB)
#define PG8_STAGE(bufoff, gbase, voff) do { _Pragma("unroll") for (int _i = 0; _i < 2; ++_i) \
        __builtin_amdgcn_global_load_lds((const unsigned*)((const char*)(gbase) + (voff)[_i]), (LAS unsigned*)(lds + (bufoff) + ldsw + _i * 8192), 16, 0, 0); } while (0)
#define PG8_LDA(dst, b, h) do { _Pragma("unroll") for (int m = 0; m < 4; ++m) _Pragma("unroll") for (int k = 0; k < 2; ++k) dst[m][k] = *(const LAS bf16x8*)(lds + PG8_SA(b, h) + aoff + m * 2048 + k * 1024); } while (0)
#define PG8_LDB(dst, b, h) do { _Pragma("unroll") for (int n = 0; n < 2; ++n) _Pragma("unroll") for (int k = 0; k < 2; ++k) dst[n][k] = *(const LAS bf16x8*)(lds + PG8_SB(b, h) + boff + n * 2048 + k * 1024); } while (0)
#define PG8_MMA(ai, bj, At, Bt) do { __builtin_amdgcn_s_setprio(1); _Pragma("unroll") for (int m = 0; m < 4; ++m) _Pragma("unroll") for (int n = 0; n < 2; ++n) _Pragma("unroll") for (int k = 0; k < 2; ++k) \
        acc[ai][bj][m][n] = __builtin_amdgcn_mfma_f32_16x16x32_bf16(Bt[n][k], At[m][k], acc[ai][bj][m][n], 0, 0, 0); __builtin_amdgcn_s_setprio(0); } while (0)
#define PG8_WAIT_V(n) asm volatile("s_waitcnt vmcnt(" #n ")" ::: "memory")
#define PG8_WAIT_L(n) asm volatile("s_waitcnt lgkmcnt(" #n ")" ::: "memory")
#define PG8_BAR __builtin_amdgcn_s_barrier()
#define PG8_SCHED __builtin_amdgcn_sched_barrier(0)
    Unit cur, nxt; int ui = 0;
    if (!S.next(0, cur)) return;
    f32x4 acc[2][2][4][2];
#pragma unroll
    for (int a = 0; a < 2; ++a)
#pragma unroll
        for (int b = 0; b < 2; ++b)
#pragma unroll
            for (int m = 0; m < 4; ++m)
#pragma unroll
                for (int n = 0; n < 2; ++n) acc[a][b][m][n] = (f32x4){0.f, 0.f, 0.f, 0.f};
    bf16x8 At[4][2], B0[2][2], B1[2][2];
    const char* cA = (const char*)g.A + (size_t)cur.pm * tA + (size_t)cur.pn * g.a_pn_off; const char* cB = (const char*)g.Bt + (size_t)cur.pn * tB;
    PG8_STAGE(PG8_SB(0, 0), cB, voffB); PG8_STAGE(PG8_SB(0, 1), cB + hB, voffB); PG8_STAGE(PG8_SA(0, 0), cA, voffA); PG8_STAGE(PG8_SA(0, 1), cA + hA, voffA);
    if (wr == 1) PG8_BAR;
    PG8_WAIT_V(2); PG8_BAR;
    PG8_STAGE(PG8_SB(1, 0), cB + kstep, voffB); PG8_STAGE(PG8_SA(1, 0), cA + kstep, voffA); PG8_STAGE(PG8_SB(1, 1), cB + hB + kstep, voffB);
    PG8_WAIT_V(6); PG8_BAR;
    for (;;) {
        const bool has_next = S.next(ui + 1, nxt);
        const char* nA = has_next ? (const char*)g.A + (size_t)nxt.pm * tA + (size_t)nxt.pn * g.a_pn_off : cA; const char* nB = has_next ? (const char*)g.Bt + (size_t)nxt.pn * tB : cB;
        for (int t = 0; t < nt; t += 2) {
            const bool last = (t == nt - 2);
            const size_t sk1 = g.askip ? (size_t)((t + 1) >> 1) * kstep : 0, sk2 = g.askip ? (size_t)((t + 2) >> 1) * kstep : 0, sk3 = g.askip ? (size_t)((t + 3) >> 1) * kstep : 0;
            const char* a1 = cA + (size_t)(t + 1) * kstep + sk1;
            const char* a2 = last ? nA : cA + (size_t)(t + 2) * kstep + sk2; const char* b2 = last ? nB : cB + (size_t)(t + 2) * kstep;
            const char* a3 = last ? nA + kstep : cA + (size_t)(t + 3) * kstep + sk3; const char* b3 = b2 + kstep;
            PG8_LDB(B0, 0, 0); PG8_LDB(B1, 0, 1); PG8_SCHED; PG8_LDA(At, 0, 0); PG8_STAGE(PG8_SA(1, 1), a1 + hA, voffA);
            PG8_WAIT_V(8); PG8_WAIT_L(0); PG8_BAR; PG8_MMA(0, 0, At, B0); PG8_MMA(0, 1, At, B1); PG8_BAR; PG8_SCHED;
            PG8_LDA(At, 0, 1); PG8_STAGE(PG8_SB(0, 0), b2, voffB); PG8_STAGE(PG8_SB(0, 1), b2 + hB, voffB); PG8_STAGE(PG8_SA(0, 0), a2, voffA);
            PG8_WAIT_V(8); PG8_WAIT_L(0); PG8_BAR; PG8_MMA(1, 0, At, B0); PG8_MMA(1, 1, At, B1); PG8_BAR; PG8_SCHED;
            PG8_LDB(B0, 1, 0); PG8_LDB(B1, 1, 1); PG8_SCHED; PG8_LDA(At, 1, 0); PG8_STAGE(PG8_SA(0, 1), a2 + hA, voffA);
            PG8_WAIT_V(8); PG8_WAIT_L(0); PG8_BAR; PG8_MMA(0, 0, At, B0); PG8_MMA(0, 1, At, B1); PG8_BAR; PG8_SCHED;
            PG8_LDA(At, 1, 1); PG8_STAGE(PG8_SB(1, 0), b3, voffB); PG8_STAGE(PG8_SB(1, 1), b3 + hB, voffB); PG8_STAGE(PG8_SA(1, 0), a3, voffA);
            PG8_WAIT_V(8); PG8_WAIT_L(0); PG8_BAR; PG8_MMA(1, 0, At, B0); PG8_MMA(1, 1, At, B1); PG8_BAR; PG8_SCHED;
        }
        if (wr == 0) PG8_BAR;
        { const int l2 = otid(wv) & 63; E(acc, cur, wr, wc, l2 & 15, l2 >> 4); }
        if (!has_next) break;
#pragma unroll
        for (int a = 0; a < 2; ++a)
#pragma unroll
            for (int b = 0; b < 2; ++b)
#pragma unroll
                for (int m = 0; m < 4; ++m)
#pragma unroll
                    for (int n = 0; n < 2; ++n) acc[a][b][m][n] = (f32x4){0.f, 0.f, 0.f, 0.f};
        cur = nxt; cA = nA; cB = nB; ++ui;
        if (wr == 1) PG8_BAR;
    }
    PG8_WAIT_V(0);
    PG8_BAR;
#undef PG8_SA
#undef PG8_SB
#undef PG8_STAGE
#undef PG8_LDA
#undef PG8_LDB
#undef PG8_MMA
#undef PG8_WAIT_V
#undef PG8_WAIT_L
#undef PG8_BAR
#undef PG8_SCHED
}
}

namespace att {
constexpr int NW = 8, QBLK = 32, KVBLK = 64;
constexpr int SHM_V = KVBLK * 128 * 2, SHM_K = KVBLK * 192 * 2;
constexpr int NVS = 3;
constexpr int QR_OFF = NVS * SHM_V + 2 * SHM_K + NW * 64 * 4;
constexpr int LDS_BYTES = QR_OFF + NW * 4096;
constexpr float THR2 = 11.5415603f;
#define KSWZ(row, colB) ((row) * 384 + ((colB) ^ ((((row) >> 1) & 7) << 4)))
#define SBAR() __builtin_amdgcn_sched_barrier(0)
#define LDS_BARRIER() do { SBAR(); asm volatile("s_waitcnt lgkmcnt(0)" ::: "memory"); __builtin_amdgcn_s_barrier(); SBAR(); } while (0)
DI int crow(int r, int hi) { return (r & 3) + 8 * (r >> 2) + 4 * hi; }

DI void partialSM(f32x16& p0, f32x16& p1, float& m_reg, f32x16& negm, float& alpha, bool first) {
    float pmax = p0[0];
#pragma unroll
    for (int r = 1; r < 16; ++r) pmax = fmaxf(pmax, p0[r]);
#pragma unroll
    for (int r = 0; r < 16; ++r) pmax = fmaxf(pmax, p1[r]);
    { auto rr = __builtin_amdgcn_permlane32_swap(__float_as_uint(pmax), __float_as_uint(pmax), false, false);
      pmax = fmaxf(__uint_as_float(rr[0]), __uint_as_float(rr[1])); }
    if (__builtin_expect(!first && __all(pmax <= THR2), 1)) { alpha = 1.f; }
    else { const float delta = first ? pmax : fmaxf(pmax, 0.f); alpha = first ? 0.f : __builtin_amdgcn_exp2f(-delta); m_reg += delta;
#pragma unroll
        for (int r = 0; r < 16; ++r) { p0[r] = p0[r] - delta; p1[r] = p1[r] - delta; negm[r] = -m_reg; } }
#pragma unroll
    for (int r = 0; r < 16; ++r) p0[r] = __builtin_amdgcn_exp2f(p0[r]);
}
DI void finishSM(f32x16& p0, f32x16& p1, float alpha, float& l_reg, bf16x8& pa0, bf16x8& pa1, bf16x8& pa2, bf16x8& pa3) {
#pragma unroll
    for (int r = 0; r < 16; ++r) p1[r] = __builtin_amdgcn_exp2f(p1[r]);
    float ps = 0;
#pragma unroll
    for (int r = 0; r < 16; ++r) ps += p0[r];
#pragma unroll
    for (int r = 0; r < 16; ++r) ps += p1[r];
    { auto rr = __builtin_amdgcn_permlane32_swap(__float_as_uint(ps), __float_as_uint(ps), false, false);
      ps = __uint_as_float(rr[0]) + __uint_as_float(rr[1]); }
    l_reg = l_reg * alpha + ps;
#define PK4(P, BASE, OUT) do { unsigned a0 = cvt_pk_bf16(P[BASE + 0], P[BASE + 1]), a1 = cvt_pk_bf16(P[BASE + 2], P[BASE + 3]);   \
    unsigned b0 = cvt_pk_bf16(P[BASE + 4], P[BASE + 5]), b1 = cvt_pk_bf16(P[BASE + 6], P[BASE + 7]);                              \
    auto r0 = __builtin_amdgcn_permlane32_swap(a0, b0, false, false); auto r1 = __builtin_amdgcn_permlane32_swap(a1, b1, false, false); \
    u32x4 w = {r0[0], r1[0], r0[1], r1[1]}; OUT = *reinterpret_cast<bf16x8*>(&w); } while (0)
    PK4(p0, 0, pa0); PK4(p0, 8, pa1); PK4(p1, 0, pa2); PK4(p1, 8, pa3);
#undef PK4
}
DI void qkt(f32x16& p0, f32x16& p1, const f32x16& negm, const char* Ks, const bf16x8* qr, const char* qrl, const int (&kb)[4]) {
    bf16x8 b0[3], b1[3];
#define KLD(d) do { const char* kp_ = Ks + kb[(d) & 3] + ((d) >> 2) * 128; b0[(d) % 3] = *reinterpret_cast<const bf16x8*>(kp_); b1[(d) % 3] = *reinterpret_cast<const bf16x8*>(kp_ + 32 * 384); } while (0)
    KLD(0); KLD(1);
    __builtin_amdgcn_s_setprio(1);
#pragma unroll
    for (int d0 = 0; d0 < 12; ++d0) {
        if (d0 + 2 < 12) KLD(d0 + 2);
        SBAR();
        const bf16x8 qf = d0 < 8 ? qr[d0 < 8 ? d0 : 0] : *reinterpret_cast<const bf16x8*>(qrl + (d0 - 8) * 1024);
        p0 = __builtin_amdgcn_mfma_f32_32x32x16_bf16(b0[d0 % 3], qf, d0 == 0 ? negm : p0, 0, 0, 0);
        p1 = __builtin_amdgcn_mfma_f32_32x32x16_bf16(b1[d0 % 3], qf, d0 == 0 ? negm : p1, 0, 0, 0);
        SBAR(); }
    __builtin_amdgcn_s_setprio(0);
#undef KLD
}
DI int v_st(int k, int c) { const int kk = (k & ~0xC) | ((k & 4) << 1) | ((k & 8) >> 1); return ((kk >> 3) * 4 + (c >> 5)) * 512 + ((kk & 7) * 32 + (c & 31)) * 2; }
DI int v_rd_base(int lane) { return ((lane & 3) << 3) | (((lane >> 2) & 3) << 6) | (((lane >> 4) & 1) << 5) | (((lane >> 5) & 1) << 8); }
constexpr int v_rd_off(int d0, int ks, int half) { return d0 * 512 + ks * 4096 + half * 2048; }
template <int OFF> DI s16x4 tr_read(int vb) {
    s16x4 r; asm volatile("ds_read_b64_tr_b16 %0, %1 offset:%2" : "=&v"(r) : "v"(vb), "i"(OFF) : "memory"); return r;
}
#define PV_READS(D0, L0, H0, L1, H1, L2, H2, L3, H3) do { L0 = tr_read<v_rd_off(D0, 0, 0)>(vb); H0 = tr_read<v_rd_off(D0, 0, 1)>(vb); L1 = tr_read<v_rd_off(D0, 1, 0)>(vb); H1 = tr_read<v_rd_off(D0, 1, 1)>(vb); \
    L2 = tr_read<v_rd_off(D0, 2, 0)>(vb); H2 = tr_read<v_rd_off(D0, 2, 1)>(vb); L3 = tr_read<v_rd_off(D0, 3, 0)>(vb); H3 = tr_read<v_rd_off(D0, 3, 1)>(vb); } while (0)
#define PK(L, H) (bf16x8){L[0], L[1], L[2], L[3], H[0], H[1], H[2], H[3]}
#define PV_MMA(od, L0, H0, L1, H1, L2, H2, L3, H3) do { od = __builtin_amdgcn_mfma_f32_32x32x16_bf16(pa0, PK(L0, H0), od, 0, 0, 0); od = __builtin_amdgcn_mfma_f32_32x32x16_bf16(pa1, PK(L1, H1), od, 0, 0, 0); \
    od = __builtin_amdgcn_mfma_f32_32x32x16_bf16(pa2, PK(L2, H2), od, 0, 0, 0); od = __builtin_amdgcn_mfma_f32_32x32x16_bf16(pa3, PK(L3, H3), od, 0, 0, 0); } while (0)
DI void pv_d0(f32x16* o, int vb, bf16x8 pa0, bf16x8 pa1, bf16x8 pa2, bf16x8 pa3) {
    s16x4 a0, a1, a2, a3, a4, a5, a6, a7, b0, b1, b2, b3, b4, b5, b6, b7;
    PV_READS(0, a0, a1, a2, a3, a4, a5, a6, a7);
    PV_READS(1, b0, b1, b2, b3, b4, b5, b6, b7);
    asm volatile("s_waitcnt lgkmcnt(8)" ::: "memory"); SBAR();
    PV_MMA(o[0], a0, a1, a2, a3, a4, a5, a6, a7); SBAR();
    PV_READS(2, a0, a1, a2, a3, a4, a5, a6, a7);
    asm volatile("s_waitcnt lgkmcnt(8)" ::: "memory"); SBAR();
    PV_MMA(o[1], b0, b1, b2, b3, b4, b5, b6, b7); SBAR();
    PV_READS(3, b0, b1, b2, b3, b4, b5, b6, b7);
    asm volatile("s_waitcnt lgkmcnt(8)" ::: "memory"); SBAR();
    PV_MMA(o[2], a0, a1, a2, a3, a4, a5, a6, a7); SBAR();
    asm volatile("s_waitcnt lgkmcnt(0)" ::: "memory"); SBAR();
    PV_MMA(o[3], b0, b1, b2, b3, b4, b5, b6, b7);
}
#undef PV_READS
#undef PV_MMA
#undef PK

DI void attn_unit(const bf16_t* __restrict__ Qb, const bf16_t* __restrict__ Kn, const bf16_t* __restrict__ Kr, const bf16_t* __restrict__ Vh,
                  bf16_t* Ob, int seq, char* lds, int wv, const float* __restrict__ rope, int pos0) {
    const int tid = otid(wv), wid = tid >> 6, lane = tid & 63, r32 = lane & 31, hi = lane >> 5;
    char* V_lds = lds; char* K_lds = lds + NVS * SHM_V;
    float* ws = (float*)(lds + NVS * SHM_V + 2 * SHM_K) + wid * 64; float* li_l = ws; float* al_l = ws + 32;
    float m_reg = 0.f, l_reg = 0; f32x16 o[4]; bf16x8 qr[8]; f32x16 negm;
#pragma unroll
    for (int r = 0; r < 16; ++r) negm[r] = 0.f;
    char* qrl = lds + QR_OFF + wid * 4096 + lane * 16;
#pragma unroll
    for (int d = 0; d < 4; ++d)
#pragma unroll
        for (int r = 0; r < 16; ++r) o[d][r] = 0.f;
    const bf16_t* Qw = Qb + (size_t)(wid * QBLK + r32) * 1536 + hi * 8;
#pragma unroll
    for (int d0 = 0; d0 < 8; ++d0) qr[d0] = gld_bf8(Qw + d0 * 16);
#pragma unroll
    for (int d0 = 8; d0 < 12; ++d0) {
        const u32x4 raw = gld_u4(Qw + d0 * 16);
        const float* cs = rope + ((size_t)(pos0 + wid * QBLK + r32) * 32 + 4 * (2 * (d0 - 8) + hi)) * 2;
        const f32x4 ca = gld_f4(cs), cb = gld_f4(cs + 4);
        const float x10 = bf2f(raw.x & 0xffff), x11 = bf2f(raw.x >> 16), x12 = bf2f(raw.y & 0xffff), x13 = bf2f(raw.y >> 16);
        const float x20 = bf2f(raw.z & 0xffff), x21 = bf2f(raw.z >> 16), x22 = bf2f(raw.w & 0xffff), x23 = bf2f(raw.w >> 16);
        u32x4 w;
        w.x = cvt_pk_bf16(x10 * ca[0] - x20 * ca[1], x11 * ca[2] - x21 * ca[3]); w.y = cvt_pk_bf16(x12 * cb[0] - x22 * cb[1], x13 * cb[2] - x23 * cb[3]);
        w.z = cvt_pk_bf16(x20 * ca[0] + x10 * ca[1], x21 * ca[2] + x11 * ca[3]); w.w = cvt_pk_bf16(x22 * cb[0] + x12 * cb[1], x23 * cb[2] + x13 * cb[3]);
        *reinterpret_cast<u32x4*>(qrl + (d0 - 8) * 1024) = w; }
    const int sr = tid >> 4, sc = (tid & 15) * 8, vst0 = v_st(sr, sc), vst1 = v_st(32 + sr, sc);
    const int kr_ = tid >> 3, kc = (tid & 7) * 8;
    const int kst0 = KSWZ(kr_, kc * 2), kst1 = KSWZ(kr_, (64 + kc) * 2), kst2 = KSWZ(kr_, (128 + kc) * 2);
    const int vb0 = (int)(uintptr_t)V_lds + v_rd_base(lane);
    int kb[4];
#pragma unroll
    for (int i = 0; i < 4; ++i) kb[i] = KSWZ(r32, (i * 16 + hi * 8) * 2);
    bf16x8 vs0, vs1, ks0, ks1, ks2;
    const unsigned offV0 = (unsigned)(sr * 1024 + sc) * 2u, offK0 = (unsigned)(kr_ * 1024 + kc) * 2u, offR = (unsigned)(kr_ * 64 + kc) * 2u;
#define SLOAD(k0) do { const char* vt_ = (const char*)(Vh + (size_t)(k0) * 1024); const char* kt_ = (const char*)(Kn + (size_t)(k0) * 1024); const char* rt_ = (const char*)(Kr + (size_t)(k0) * 64); \
    vs0 = gld_bf8(vt_ + offV0); vs1 = gld_bf8(vt_ + offV0 + 65536u); \
    ks0 = gld_bf8(kt_ + offK0); ks1 = gld_bf8(kt_ + offK0 + 128u); \
    ks2 = gld_bf8(rt_ + offR); } while (0)
#define SWRITE(vo, ko) do { *(bf16x8*)(V_lds + (vo) + vst0) = vs0; *(bf16x8*)(V_lds + (vo) + vst1) = vs1; \
    *(bf16x8*)(K_lds + (ko) + kst0) = ks0; *(bf16x8*)(K_lds + (ko) + kst1) = ks1; *(bf16x8*)(K_lds + (ko) + kst2) = ks2; } while (0)
#define SWAIT() asm volatile("s_waitcnt vmcnt(0)" ::: "memory")
#define RESC(a) do { if (__any((a) < 1.f)) { if (hi == 0) al_l[r32] = (a); asm volatile("s_waitcnt lgkmcnt(0)" ::: "memory"); \
    _Pragma("unroll") for (int d = 0; d < 4; ++d) _Pragma("unroll") for (int r = 0; r < 16; ++r) o[d][r] *= al_l[crow(r, hi)]; } } while (0)
    f32x16 pA0, pA1; float alA; bf16x8 pa0, pa1, pa2, pa3; const int NT = seq / KVBLK;
    const bool grpB = (wv >= 4);
    int vcur = 0, kcur = 0;
    int vnxt = SHM_V, knxt = SHM_K;
#define STAGE_NEXT(jn) do { SWAIT(); SWRITE(vnxt, knxt); SBAR(); if ((jn) + 1 < NT) SLOAD(((jn) + 1) * KVBLK); SBAR(); asm volatile("s_waitcnt lgkmcnt(0)" ::: "memory"); __builtin_amdgcn_s_barrier(); SBAR(); } while (0)
    SLOAD(0); SWAIT(); SWRITE(0, 0); SBAR(); SLOAD(KVBLK); LDS_BARRIER();
    for (int j = 0; j < NT; ++j) {
        qkt(pA0, pA1, negm, K_lds + kcur, qr, qrl, kb); partialSM(pA0, pA1, m_reg, negm, alA, j == 0);
        RESC(alA);
        finishSM(pA0, pA1, alA, l_reg, pa0, pa1, pa2, pa3); SBAR();
        if (grpB && j + 1 < NT) STAGE_NEXT(j + 1);
        pv_d0(o, vb0 + vcur, pa0, pa1, pa2, pa3);
        SBAR();
        if (!grpB && j + 1 < NT) STAGE_NEXT(j + 1);
        vcur = vnxt; kcur = knxt; vnxt = (vnxt == (NVS - 1) * SHM_V) ? 0 : vnxt + SHM_V; knxt ^= SHM_K;
    }
#undef STAGE_NEXT
    if (hi == 0) li_l[r32] = l_reg; asm volatile("s_waitcnt lgkmcnt(0)" ::: "memory");
    bf16_t* Ow = Ob + (size_t)(wid * QBLK + 4 * hi) * 1536 + r32;
    asm volatile("" : "+v"(Ow));
#pragma unroll
    for (int r = 0; r < 16; ++r) { const int orow = crow(r, hi); const float rl = __builtin_amdgcn_rcpf(li_l[orow]);
        bf16_t* Or = Ow + ((r & 3) + 8 * (r >> 2)) * 1536;
#pragma unroll
        for (int d0 = 0; d0 < 4; ++d0) gst_h(Or + d0 * 32, f2bf(o[d0][r] * rl)); }
    LDS_BARRIER();
#undef SLOAD
#undef SWRITE
#undef SWAIT
#undef RESC
}
}

namespace fft {
DI s16x4 trr(unsigned addr) { s16x4 r; asm volatile("ds_read_b64_tr_b16 %0, %1" : "=&v"(r) : "v"(addr) : "memory"); return r; }
DI int crow(int r, int hi) { return (r & 3) + 8 * (r >> 2) + 4 * hi; }

template <int NN, int STAGE>
DI void fft_phase(char* lds, const bf16_t* __restrict__ src, bf16_t* __restrict__ dst, int nbatch, int G, int bid, int wv) {
    constexpr int S = NN * NN;
    constexpr int CW = (STAGE == 1) ? 256 : 128;
    constexpr int NCC = 1024 / CW;
    constexpr int KR = (STAGE == 1) ? NN : 2 * NN;
    constexpr int RS = CW * 2 + 64;
    constexpr int KS = KR / 16;
    constexpr int NROWT = NN / 16;
    constexpr int NCPART = 8 / NROWT;
    constexpr int NCBW = (CW / 32) / NCPART;
    constexpr int C16 = CW / 8;
    constexpr int NLD = KR * C16 / 512;
    const int tid = otid(wv), wid = tid >> 6, lane = tid & 63, m32 = lane & 31, h = lane >> 5;
    const int rt = wid % NROWT, cpart = wid / NROWT;
    const int nunits = nbatch * NN * NCC;
    bf16x8 areg[KS];
#pragma unroll
    for (int s = 0; s < KS; ++s) {
        float v[8];
#pragma unroll
        for (int j = 0; j < 8; ++j) { const int k = 16 * s + 8 * h + j;
            if (STAGE == 1) { const int c = 16 * rt + (m32 & 15), reim = m32 >> 4; const float fr = (float)((k * c) & (NN - 1)) * (1.0f / NN);
                v[j] = reim ? -sin2pi(fr) : cos2pi(fr); }
            else { const int R = 32 * rt + m32, ro = R / NN, d = R % NN, ri = k / NN, b = k % NN; const float fr = (float)((b * d) & (NN - 1)) * (1.0f / NN);
                const float cs = cos2pi(fr), sn = sin2pi(fr); v[j] = (ro == 0) ? (ri == 0 ? cs : sn) : (ri == 0 ? -sn : cs); } }
        u32x4 w = {cvt_pk_bf16(v[0], v[1]), cvt_pk_bf16(v[2], v[3]), cvt_pk_bf16(v[4], v[5]), cvt_pk_bf16(v[6], v[7])};
        areg[s] = *reinterpret_cast<bf16x8*>(&w);
    }
    const unsigned ldsb = (unsigned)(uintptr_t)lds;
    const int i16 = lane & 15, q = i16 >> 2, p = i16 & 3, blk = (lane >> 4) & 1;
    const unsigned rbase = ldsb + (unsigned)((8 * h + q) * RS + (16 * blk + 4 * p) * 2);
    u32x4 pre[NLD];
    auto unit_src = [&](int u, int& bt, int& x, int& cc) -> const bf16_t* {
        cc = u % NCC; const int t = u / NCC; x = t % NN; bt = t / NN;
        if (STAGE == 1) return src + ((size_t)bt * S + x) * 1024 + cc * CW;
        else return src + ((size_t)(bt * NN + x) * 2 * NN) * 1024 + cc * CW;
    };
    constexpr size_t ROWSTEP = (STAGE == 1) ? (size_t)NN * 1024 : 1024;
    int u = bid;
    if (u < nunits) { int bt, x, cc; const bf16_t* sp = unit_src(u, bt, x, cc);
#pragma unroll
        for (int i = 0; i < NLD; ++i) { const int ch = tid + i * 512, row = ch / C16, c16 = ch % C16; pre[i] = gld_u4(sp + (size_t)row * ROWSTEP + c16 * 8); } }
    for (; u < nunits; u += G) {
        int bt, x, cc; (void)unit_src(u, bt, x, cc);
        LDS_BARRIER();
#pragma unroll
        for (int i = 0; i < NLD; ++i) { const int ch = tid + i * 512, row = ch / C16, c16 = ch % C16; *(u32x4*)(lds + row * RS + c16 * 16) = pre[i]; }
        LDS_BARRIER();
        if (u + G < nunits) { int bt2, x2, cc2; const bf16_t* sp = unit_src(u + G, bt2, x2, cc2);
#pragma unroll
            for (int i = 0; i < NLD; ++i) { const int ch = tid + i * 512, row = ch / C16, c16 = ch % C16; pre[i] = gld_u4(sp + (size_t)row * ROWSTEP + c16 * 8); } }
        float tc[8], tsn[8];
        if (STAGE == 1) {
#pragma unroll
            for (int r = 0; r < 8; ++r) { const int c = 16 * rt + crow(r, h); const float fr = (float)((x * c) & (S - 1)) * (1.0f / S); tc[r] = cos2pi(fr); tsn[r] = sin2pi(fr); }
        }
#pragma unroll 1
        for (int cbi = 0; cbi < NCBW; ++cbi) {
            const int cb = cpart * NCBW + cbi;
            f32x16 acc;
#pragma unroll
            for (int r = 0; r < 16; ++r) acc[r] = 0.f;
            const unsigned cbase = rbase + (unsigned)(cb * 64);
#pragma unroll
            for (int s0 = 0; s0 < KS; s0 += 4) {
                s16x4 lo[4], hh[4];
#pragma unroll
                for (int i = 0; i < 4; ++i) { lo[i] = trr(cbase + (unsigned)((s0 + i) * 16 * RS)); hh[i] = trr(cbase + (unsigned)((s0 + i) * 16 * RS + 4 * RS)); }
                asm volatile("s_waitcnt lgkmcnt(0)" ::: "memory"); __builtin_amdgcn_sched_barrier(0);
#pragma unroll
                for (int i = 0; i < 4; ++i) { const bf16x8 bfr = (bf16x8){lo[i][0], lo[i][1], lo[i][2], lo[i][3], hh[i][0], hh[i][1], hh[i][2], hh[i][3]};
                    acc = __builtin_amdgcn_mfma_f32_32x32x16_bf16(areg[s0 + i], bfr, acc, 0, 0, 0); }
            }
            const int col = cc * CW + cb * 32 + m32;
            if (STAGE == 1) {
#pragma unroll
                for (int r = 0; r < 8; ++r) { const int c = 16 * rt + crow(r, h); const float tr_ = acc[r], ti = acc[r + 8];
                    const float o_r = tr_ * tc[r] + ti * tsn[r], o_i = ti * tc[r] - tr_ * tsn[r];
                    bf16_t* dp = dst + (((size_t)(bt * NN + c) * 2) * NN + x) * 1024 + col;
                    gst_h(dp, f2bf(o_r)); gst_h(dp + (size_t)NN * 1024, f2bf(o_i)); }
            } else {
#pragma unroll
                for (int r = 0; r < 16; ++r) { const int R = 32 * rt + crow(r, h), ro = R / NN, d = R % NN;
                    const size_t tok = (size_t)bt * S + x + (size_t)NN * d;
                    gst_h(dst + tok * 2048 + (col >> 8) * 512 + ro * 256 + (col & 255), f2bf(acc[r])); }
            }
        }
    }
    __syncthreads();
}
}

struct Args {
    const float* xp; const float* xs; const float* norm_g; const float* fnet_w; const float* fnet_b; const float* w_down; const float* q_norm; const float* w_uq;
    const float* kv_norm; const float* w_ukv; const float* w_o; const float* w_gate; const float* w_up; const float* w_fdown;
    float* out; unsigned char* ws; int ph_lo, ph_hi;
};

enum { JOB_FN = 0, JOB_DFT, JOB_DN, JOB_UQ, JOB_UKV, JOB_WO, JOB_GU, JOB_FD };
DI float prep_val(const Args& a, int job, int layer, int k, int n) {
    switch (job) {
    case JOB_FN: return a.fnet_w[(size_t)k * 1024 + n];
    case JOB_DFT: { const int ri = k >> 8, n2 = k & 255; const float fr = (float)((n2 * n) & 255) * (1.0f / 256); return ri ? sin2pi(fr) : cos2pi(fr); }
    case JOB_DN: return n < 576 ? a.norm_g[(4 + 0) * 1024 + k] * a.w_down[(size_t)k * 576 + n] : 0.f;
    case JOB_UQ: { const int hh = n / 192, c = n % 192; int sc = c; if (c >= 128) { const int p = c - 128; sc = 128 + 32 * ((p >> 2) & 1) + 4 * (p >> 3) + (p & 3); }
        return a.q_norm[k] * a.w_uq[(size_t)k * 1536 + hh * 192 + sc] * QSCALE; }
    case JOB_UKV: return a.kv_norm[k] * a.w_ukv[(size_t)k * 2048 + n];
    case JOB_WO: return a.w_o[(size_t)k * 1024 + n];
    case JOB_GU: { const int pn = n >> 8, isup = (n >> 7) & 1, col = pn * 128 + (n & 127); const float* w = (isup ? a.w_up : a.w_gate) + (size_t)layer * 1024 * DFF;
        return a.norm_g[(layer * 4 + 2) * 1024 + k] * w[(size_t)k * DFF + col]; }
    default: return a.w_fdown[(size_t)layer * DFF * 1024 + (size_t)k * 1024 + n];
    }
}
DI void prep_job(const Args& a, int job, int layer, int N, int K, bf16_t* dst, float* scr, int item0, int& item_base, int G, int bid, int wv) {
    const int tn = N / 64, tk = K / 64, n_items = tn * tk, tid = otid(wv);
    int first = item_base; item_base += n_items;
    int i = bid - (first % G); if (i < 0) i += G;
    for (; i < n_items; i += G) {
        const int n0 = (i % tn) * 64, k0 = (i / tn) * 64;
        __syncthreads();
#pragma unroll
        for (int e8 = 0; e8 < 8; ++e8) { const int e = tid + e8 * 512, kk = e >> 6, nn = e & 63; scr[nn * 65 + kk] = prep_val(a, job, layer, k0 + kk, n0 + nn); }
        __syncthreads();
#pragma unroll
        for (int e4 = 0; e4 < 4; ++e4) { const int e = tid + e4 * 512, nn = e >> 5, k2 = (e & 31) * 2;
            *(unsigned*)(dst + (size_t)(n0 + nn) * K + k0 + k2) = cvt_pk_bf16(scr[nn * 65 + k2], scr[nn * 65 + k2 + 1]); }
    }
    (void)item0;
}

DI void row_first(const Args& a, bf16_t* H, int G, int bid, int wv) {
    const int tid_ = otid(wv), wid = tid_ >> 6, lane = tid_ & 63;
    const float* g = a.norm_g;
    constexpr int NR = 4; const int rstep = G * 8;
    for (int row0 = bid * 8 + wid; row0 < T_ALL; row0 += rstep * NR) {
        f32x4 x[NR][4];
#pragma unroll
        for (int q = 0; q < NR; ++q) { const int row = min(row0 + q * rstep, T_ALL - 1);
            const float* xr = row < T_HALF ? a.xp + (size_t)row * 1024 : a.xs + (size_t)(row - T_HALF) * 1024;
#pragma unroll
            for (int hv = 0; hv < 2; ++hv) { x[q][2 * hv] = gld_f4(xr + hv * 512 + lane * 8); x[q][2 * hv + 1] = gld_f4(xr + hv * 512 + lane * 8 + 4); } }
#pragma unroll
        for (int q = 0; q < NR; ++q) { const int row = row0 + q * rstep; if (row >= T_ALL) continue;
            float ss = 0.f;
#pragma unroll
            for (int i = 0; i < 4; ++i)
#pragma unroll
                for (int j = 0; j < 4; ++j) ss += x[q][i][j] * x[q][i][j];
            ss = wave_sum(ss); const float r = rsqrtf(ss * (1.0f / 1024) + NORM_EPS);
#pragma unroll
            for (int hv = 0; hv < 2; ++hv) { const int c = hv * 512 + lane * 8; const f32x4 g0 = gld_f4(g + c), g1 = gld_f4(g + c + 4);
                const f32x4 y0 = x[q][2 * hv] * r * g0, y1 = x[q][2 * hv + 1] * r * g1;
                u32x4 w = {cvt_pk_bf16(y0[0], y0[1]), cvt_pk_bf16(y0[2], y0[3]), cvt_pk_bf16(y1[0], y1[1]), cvt_pk_bf16(y1[2], y1[3])};
                gst_u4(H + (size_t)row * 1024 + c, w); } }
    }
}
DI void row_mid(const bf16_t* m, const float* gpost, const float* xf0, const float* xf1, const bf16_t* xb_in, bf16_t* xb_out, float* rs_out, float* out_f, int G, int bid, int wv) {
    const int tid_ = otid(wv), wid = tid_ >> 6, lane = tid_ & 63;
    constexpr int NR = 2;
    const int rstep = G * 8, step = rstep * NR;
#define RM_LOAD(X, MW, R0) do { _Pragma("unroll") for (int q = 0; q < NR; ++q) { const int row = min((R0) + q * rstep, T_ALL - 1); \
        _Pragma("unroll") for (int hv = 0; hv < 2; ++hv) { const int c = hv * 512 + lane * 8; \
            if (xb_in) { const u32x4 w = gld_u4(xb_in + (size_t)row * 1024 + c); \
                X[q][2 * hv] = (f32x4){bf2f(w.x & 0xffff), bf2f(w.x >> 16), bf2f(w.y & 0xffff), bf2f(w.y >> 16)}; \
                X[q][2 * hv + 1] = (f32x4){bf2f(w.z & 0xffff), bf2f(w.z >> 16), bf2f(w.w & 0xffff), bf2f(w.w >> 16)}; } \
            else { const float* xr = row < T_HALF ? xf0 + (size_t)row * 1024 : xf1 + (size_t)(row - T_HALF) * 1024; \
                X[q][2 * hv] = gld_f4(xr + c); X[q][2 * hv + 1] = gld_f4(xr + c + 4); } \
            MW[q][hv] = gld_u4(m + (size_t)row * 1024 + c); } } } while (0)
#define RM_PROC(X, MW, R0) do { _Pragma("unroll") for (int q = 0; q < NR; ++q) { const int row = (R0) + q * rstep; if (row >= T_ALL) continue; \
        f32x4 mv[4]; float ss = 0.f; \
        _Pragma("unroll") for (int hv = 0; hv < 2; ++hv) { const u32x4 w = MW[q][hv]; \
            mv[2 * hv] = (f32x4){bf2f(w.x & 0xffff), bf2f(w.x >> 16), bf2f(w.y & 0xffff), bf2f(w.y >> 16)}; \
            mv[2 * hv + 1] = (f32x4){bf2f(w.z & 0xffff), bf2f(w.z >> 16), bf2f(w.w & 0xffff), bf2f(w.w >> 16)}; } \
        _Pragma("unroll") for (int i = 0; i < 4; ++i) _Pragma("unroll") for (int j = 0; j < 4; ++j) ss += mv[i][j] * mv[i][j]; \
        ss = wave_sum(ss); const float r1 = rsqrtf(ss * (1.0f / 1024) + NORM_EPS); \
        float s2 = 0.f; \
        _Pragma("unroll") for (int hv = 0; hv < 2; ++hv) { const int c = hv * 512 + lane * 8; const f32x4 g0 = gld_f4(gpost + c), g1 = gld_f4(gpost + c + 4); \
            X[q][2 * hv] = X[q][2 * hv] + mv[2 * hv] * r1 * g0; X[q][2 * hv + 1] = X[q][2 * hv + 1] + mv[2 * hv + 1] * r1 * g1; \
            if (out_f) { gst_f4(out_f + (size_t)row * 1024 + c, X[q][2 * hv]); gst_f4(out_f + (size_t)row * 1024 + c + 4, X[q][2 * hv + 1]); } \
            else { const f32x4 y0 = X[q][2 * hv], y1 = X[q][2 * hv + 1]; \
                u32x4 w = {cvt_pk_bf16(y0[0], y0[1]), cvt_pk_bf16(y0[2], y0[3]), cvt_pk_bf16(y1[0], y1[1]), cvt_pk_bf16(y1[2], y1[3])}; \
                gst_u4(xb_out + (size_t)row * 1024 + c, w); } } \
        if (rs_out) { \
            _Pragma("unroll") for (int i = 0; i < 4; ++i) _Pragma("unroll") for (int j = 0; j < 4; ++j) s2 += X[q][i][j] * X[q][i][j]; \
            s2 = wave_sum(s2); if (lane == 0) rs_out[row] = rsqrtf(s2 * (1.0f / 1024) + NORM_EPS); } } } while (0)
    f32x4 xa[NR][4], xb2[NR][4]; u32x4 ma[NR][2], mb[NR][2];
    int row0 = bid * 8 + wid;
    if (row0 < T_ALL) RM_LOAD(xa, ma, row0);
    while (row0 < T_ALL) {
        const int rowB = row0 + step; const bool hb = rowB < T_ALL;
        if (hb) RM_LOAD(xb2, mb, rowB);
        RM_PROC(xa, ma, row0);
        if (!hb) break;
        const int rowA = rowB + step; const bool ha = rowA < T_ALL;
        if (ha) RM_LOAD(xa, ma, rowA);
        RM_PROC(xb2, mb, rowB);
        if (!ha) break;
        row0 = rowA;
    }
#undef RM_LOAD
#undef RM_PROC
}
DI void row_mla(const bf16_t* down, const float* rope, bf16_t* cq, bf16_t* ckv, bf16_t* kr, int G, int bid, int wv) {
    const int tid_ = otid(wv), wid = tid_ >> 6, lane = tid_ & 63;
    constexpr int NR = 4;
    const int rstep = G * 8, i = lane & 31;
    for (int row0 = bid * 8 + wid; row0 < T_ALL; row0 += rstep * NR) {
        u32x2 av[NR], bv[NR]; unsigned short kv[NR]; float csv[NR], snv[NR];
#pragma unroll
        for (int q = 0; q < NR; ++q) { const int row = min(row0 + q * rstep, T_ALL - 1); const bf16_t* dr = down + (size_t)row * 768;
            av[q] = *(const GAS u32x2*)(dr + lane * 4); bv[q] = *(const GAS u32x2*)(dr + 256 + lane * 4); kv[q] = *(const GAS unsigned short*)(dr + 512 + lane);
            const int pos = row < T_HALF ? (row & (S_P - 1)) : (row & (S_S - 1));
            const float* rp = rope + ((size_t)pos * 32 + i) * 2; csv[q] = *(const GAS float*)rp; snv[q] = *(const GAS float*)(rp + 1); }
#pragma unroll
        for (int q = 0; q < NR; ++q) { const int row = row0 + q * rstep; if (row >= T_ALL) continue;
            const u32x2 a = av[q], b = bv[q];
            const float a0 = bf2f(a.x & 0xffff), a1 = bf2f(a.x >> 16), a2 = bf2f(a.y & 0xffff), a3 = bf2f(a.y >> 16);
            const float b0 = bf2f(b.x & 0xffff), b1 = bf2f(b.x >> 16), b2 = bf2f(b.y & 0xffff), b3 = bf2f(b.y >> 16);
            const float sa = wave_sum(a0 * a0 + a1 * a1 + a2 * a2 + a3 * a3), sb = wave_sum(b0 * b0 + b1 * b1 + b2 * b2 + b3 * b3);
            const float ra = rsqrtf(sa * (1.0f / 256) + NORM_EPS), rb = rsqrtf(sb * (1.0f / 256) + NORM_EPS);
            u32x2 wa = {cvt_pk_bf16(a0 * ra, a1 * ra), cvt_pk_bf16(a2 * ra, a3 * ra)}, wb = {cvt_pk_bf16(b0 * rb, b1 * rb), cvt_pk_bf16(b2 * rb, b3 * rb)};
            gst_u2(cq + (size_t)row * 256 + lane * 4, wa); gst_u2(ckv + (size_t)row * 256 + lane * 4, wb);
            const float xv = bf2f(kv[q]); const float xo = __shfl_xor(xv, 32);
            const float cs = csv[q], sn = snv[q];
            const float ov = lane < 32 ? (xv * cs - xo * sn) : (xv * cs + xo * sn);
            const int pidx = 8 * (i >> 2) + 4 * (lane >> 5) + (i & 3);
            gst_h(kr + (size_t)row * 64 + pidx, f2bf(ov)); }
    }
}


#define XB_TMO      128
#define XB_XCNT(j)  (256  + 64 * (j))
#define XB_XSUB(j)  (1280 + 64 * (j))
#define XB_XGEN(j)  (2304 + 64 * (j))
#define XB_TOP      3328
#define XB_TOPGEN   3392
#define XB_SPIN_CAP (1u << 22)
DI unsigned xb_ld(unsigned* p)              { return __hip_atomic_load(p, __ATOMIC_RELAXED, __HIP_MEMORY_SCOPE_AGENT); }
DI unsigned xb_add(unsigned* p, unsigned v) { return __hip_atomic_fetch_add(p, v, __ATOMIC_RELAXED, __HIP_MEMORY_SCOPE_AGENT); }
DI unsigned xb_xcc_id() { return (unsigned)__builtin_amdgcn_s_getreg((3 << 11) | 20) & 0xFu; }
#define XB_SPIN(cond, bar) do { unsigned _sp = 0; while (cond) { __builtin_amdgcn_s_sleep(1); \
    if ((++_sp & 255u) == 0u) { if (xb_ld(&(bar)[XB_TMO])) break; if (_sp > XB_SPIN_CAP) { atomicAdd(&(bar)[XB_TMO], 1u); break; } } } } while (0)
struct XcdBarrier { unsigned* bar; unsigned x; volatile LAS unsigned* st; };
DI void xcd_barrier_complete(unsigned* bar, unsigned x, unsigned& nloc, unsigned& nx) {
    const unsigned G = gridDim.x;
    unsigned sum, cnt, mine, sp = 0u;
    for (;;) {
        sum = 0u; cnt = 0u; mine = 0u;
#pragma unroll
        for (unsigned j = 0; j < 16; ++j) { const unsigned c = xb_ld(&bar[XB_XCNT(j)]); sum += c; cnt += (c > 0u) ? 1u : 0u; mine = (j == x) ? c : mine; }
        if (sum == G) break;
        __builtin_amdgcn_s_sleep(1);
        if ((++sp & 255u) == 0u) { if (xb_ld(&bar[XB_TMO])) break; if (sp > XB_SPIN_CAP) { atomicAdd(&bar[XB_TMO], 1u); break; } }
    }
    nloc = mine > 0u ? mine : 1u; nx = cnt > 0u ? cnt : 1u;
}
DI void xcd_barrier(const XcdBarrier& b, int wv) {
    asm volatile("s_waitcnt vmcnt(0)" ::: "memory");
    __syncthreads();
    if (otid(wv) == 0) {
        unsigned* bar = b.bar;
        __builtin_amdgcn_s_waitcnt(0);
        unsigned nloc = b.st[0], nx = b.st[1];
        if (nloc == 0u) { xcd_barrier_complete(bar, b.x, nloc, nx); b.st[0] = nloc; b.st[1] = nx; }
        const unsigned old = xb_add(&bar[XB_XSUB(b.x)], 1u);
        const unsigned gen = old / nloc;
        if (old + 1u == (gen + 1u) * nloc) {
            __builtin_amdgcn_fence(__ATOMIC_RELEASE, "agent");
            asm volatile("s_waitcnt vmcnt(0)" ::: "memory");
            const unsigned og = xb_add(&bar[XB_TOP], 1u);
            const unsigned tg = og / nx;
            if (og + 1u == (tg + 1u) * nx) xb_add(&bar[XB_TOPGEN], 1u);
            else XB_SPIN(xb_ld(&bar[XB_TOPGEN]) == tg, bar);
            __builtin_amdgcn_fence(__ATOMIC_ACQUIRE, "agent");
            xb_add(&bar[XB_XGEN(b.x)], 1u);
            asm volatile("s_waitcnt vmcnt(0)" ::: "memory");
        } else {
            XB_SPIN(xb_ld(&bar[XB_XGEN(b.x)]) == gen, bar);
            __builtin_amdgcn_fence(__ATOMIC_ACQUIRE, "agent");
            asm volatile("s_waitcnt vmcnt(0)" ::: "memory");
        }
    }
    __syncthreads();
}

constexpr int LDS_BYTES = 147456;
constexpr int LDS_BAR_OFF = LDS_BYTES - 64;
constexpr int NPHASE = 27;

DI unsigned char* opq(unsigned char* p) { asm volatile("" : "+s"(p)); return (unsigned char*)(__attribute__((address_space(1))) unsigned char*)p; }
__global__ void __launch_bounds__(512, 2) mega(Args a) {
    extern __shared__ __attribute__((aligned(16))) unsigned char lds[];
    cg::grid_group grid = cg::this_grid();
    const int G = gridDim.x, bid = blockIdx.x, wv = __builtin_amdgcn_readfirstlane((int)threadIdx.x >> 6);
    const int lo = a.ph_lo, hi = a.ph_hi;
#ifndef PHMASK
#define PHMASK 0xFFFFFFFFu
#endif
#define IN(k) ((((PHMASK) >> (k)) & 1u) && lo <= (k) && (k) < hi)
    XcdBarrier xbar; xbar.bar = (unsigned*)a.ws; xbar.x = xb_xcc_id(); xbar.st = (volatile LAS unsigned*)((LAS unsigned char*)lds + LDS_BAR_OFF);
    if (threadIdx.x < 2) xbar.st[threadIdx.x] = 0u;
    if (threadIdx.x == 0) (void)xb_add(&xbar.bar[XB_XCNT(xbar.x)], 1u);
    __syncthreads();
    if (lo < 0) grid.sync();
#define SYNC(k) do { if (lo <= (k) && (k) + 1 < hi) xcd_barrier(xbar, wv); } while (0)
#define WSB(off) ((bf16_t*)(opq(a.ws) + (off)))
#define LDSL ((LAS unsigned char*)lds)
#ifndef NREP
#define NREP 1
#endif
#define REP for (int rep_ = 0; rep_ < NREP; ++rep_)

    if (IN(0)) REP {
        int ib = 0; float* scr = (float*)lds;
        prep_job(a, JOB_FN, 0, 1024, 1024, WSB(WS_WFN), scr, 0, ib, G, bid, wv);
        prep_job(a, JOB_DFT, 0, 256, 512, WSB(WS_DFT), scr, 0, ib, G, bid, wv);
        prep_job(a, JOB_DN, 0, 768, 1024, WSB(WS_WDN), scr, 0, ib, G, bid, wv);
        prep_job(a, JOB_UQ, 0, 1536, 256, WSB(WS_WUQ), scr, 0, ib, G, bid, wv);
        prep_job(a, JOB_UKV, 0, 2048, 256, WSB(WS_WUKV), scr, 0, ib, G, bid, wv);
        prep_job(a, JOB_WO, 0, 1024, 1024, WSB(WS_WO), scr, 0, ib, G, bid, wv);
        prep_job(a, JOB_GU, 0, 5632, 1024, WSB(WS_WGU), scr, 0, ib, G, bid, wv);
        prep_job(a, JOB_FD, 0, 1024, 2816, WSB(WS_WFD), scr, 0, ib, G, bid, wv);
        float* rope = (float*)WSB(WS_ROPE);
        for (int e = bid * 512 + otid(wv); e < 16384 * 32; e += G * 512) { const int pos = e >> 5, i = e & 31;
            const float inv = 1.0f / powf(10000.0f, (float)(2 * i) / 64.0f); const float ang = (float)pos * inv;
            const double rev = (double)ang * 0.15915494309189535; const float fr = (float)(rev - floor(rev));
            rope[(size_t)e * 2] = cos2pi(fr); rope[(size_t)e * 2 + 1] = sin2pi(fr); }
        row_first(a, WSB(WS_H), G, bid, wv);
    }
    SYNC(0);
    if (IN(1)) REP fft::fft_phase<128, 1>((char*)lds, WSB(WS_H), WSB(WS_TP), 2, G, bid, wv);
    SYNC(1);
    if (IN(2)) REP fft::fft_phase<128, 2>((char*)lds, WSB(WS_TP), WSB(WS_PQ), 2, G, bid, wv);
    SYNC(2);
    if (IN(3)) REP { pg8::Gemm g{WSB(WS_PQ), WSB(WS_DFT), T_HALF, 1024, 512, 2048, 1024, 1, 0}; pg8::StaticOrder S; S.init(T_HALF, 1024, G, bid);
        pg8::EpiStore E{WSB(WS_H), 1024, nullptr, nullptr}; pg8::gemm_phase(LDSL, g, S, E, wv); }
    if (IN(4)) REP fft::fft_phase<64, 1>((char*)lds, WSB(WS_H) + (size_t)T_HALF * 1024, WSB(WS_TP), 8, G, bid, wv);
    SYNC(4);
    if (IN(5)) REP fft::fft_phase<64, 2>((char*)lds, WSB(WS_TP), WSB(WS_PQ), 8, G, bid, wv);
    SYNC(5);
    if (IN(6)) REP { pg8::Gemm g{WSB(WS_PQ), WSB(WS_DFT), T_HALF, 1024, 512, 2048, 1024, 1, 0}; pg8::StaticOrder S; S.init(T_HALF, 1024, G, bid);
        pg8::EpiStore E{WSB(WS_H) + (size_t)T_HALF * 1024, 1024, nullptr, nullptr}; pg8::gemm_phase(LDSL, g, S, E, wv); }
    SYNC(6);
    if (IN(7)) REP { pg8::Gemm g{WSB(WS_H), WSB(WS_WFN), T_ALL, 1024, 1024, 1024, 0, 0, 0}; pg8::StaticOrder S; S.init(T_ALL, 1024, G, bid);
        pg8::EpiStore E{WSB(WS_M), 1024, a.fnet_b, nullptr}; pg8::gemm_phase(LDSL, g, S, E, wv); }
    SYNC(7);
    if (IN(8)) REP row_mid(WSB(WS_M), a.norm_g + 1 * 1024, a.xp, a.xs, nullptr, (bf16_t*)a.out, (float*)WSB(WS_RSTD), nullptr, G, bid, wv);
    SYNC(8);
#define FFN_PHASES(base, layer, last) \
    for (int hf = 0; hf < 2; ++hf) { \
        if (IN((base) + 2 * hf)) REP { const bf16_t* xres = (layer) ? (const bf16_t*)WSB(WS_H) : (const bf16_t*)a.out;     \
            pg8::Gemm g{xres + (size_t)hf * T_HALF * 1024, WSB(WS_WGU), T_HALF, 5632, 1024, 1024, 0, 0, 0}; pg8::StaticOrder S; S.init(T_HALF, 5632, G, bid); \
            pg8::EpiSwiGLU E{WSB(WS_ACT), (const float*)WSB(WS_RSTD) + (size_t)hf * T_HALF}; pg8::gemm_phase(LDSL, g, S, E, wv); } \
        SYNC((base) + 2 * hf); \
        if (IN((base) + 2 * hf + 1)) REP { pg8::Gemm g{WSB(WS_ACT), WSB(WS_WFD), T_HALF, 1024, DFF, DFF, 0, 0, 0}; pg8::StaticOrder S; S.init(T_HALF, 1024, G, bid); \
            pg8::EpiStore E{WSB(WS_F) + (size_t)hf * T_HALF * 1024, 1024, nullptr, nullptr}; pg8::gemm_phase(LDSL, g, S, E, wv); } \
        SYNC((base) + 2 * hf + 1); \
    } \
    if (IN((base) + 4)) { if (last) row_mid(WSB(WS_F), a.norm_g + ((layer) * 4 + 3) * 1024, nullptr, nullptr, WSB(WS_H), nullptr, nullptr, a.out, G, bid, wv); \
                          else row_mid(WSB(WS_F), a.norm_g + ((layer) * 4 + 3) * 1024, nullptr, nullptr, (const bf16_t*)a.out, (bf16_t*)a.out, (float*)WSB(WS_RSTD), nullptr, G, bid, wv); } \
    SYNC((base) + 4);
#pragma unroll 1
    for (int layer = 0; layer < 2; ++layer) {
        const int base = layer ? 22 : 9;
        if (layer == 1) {
            if (IN(14)) REP { pg8::Gemm g{(const bf16_t*)a.out, WSB(WS_WDN), T_ALL, 768, 1024, 1024, 0, 0, 0}; pg8::StaticOrder S; S.init(T_ALL, 768, G, bid);
                pg8::EpiStore E{WSB(WS_DOWN), 768, nullptr, (const float*)WSB(WS_RSTD)}; pg8::gemm_phase(LDSL, g, S, E, wv); }
            SYNC(14);
            if (IN(15)) REP {
                row_mla(WSB(WS_DOWN), (const float*)WSB(WS_ROPE), WSB(WS_CQ), WSB(WS_CKV), WSB(WS_KR), G, bid, wv);
                int ib = 0; float* scr = (float*)lds;
                prep_job(a, JOB_GU, 1, 5632, 1024, WSB(WS_WGU), scr, 0, ib, G, bid, wv);
                prep_job(a, JOB_FD, 1, 1024, 2816, WSB(WS_WFD), scr, 0, ib, G, bid, wv);
                __syncthreads();
            }
            SYNC(15);
            if (IN(16)) REP { pg8::Gemm g{WSB(WS_CQ), WSB(WS_WUQ), T_ALL, 1536, 256, 256, 0, 0, 0}; pg8::StaticOrder S; S.init(T_ALL, 1536, G, bid);
                pg8::EpiStore E{WSB(WS_Q), 1536, nullptr, nullptr}; pg8::gemm_phase(LDSL, g, S, E, wv); }
#define KN_OF(hf) ((hf) ? (bf16_t*)((unsigned char*)a.out + 128 * MiB) : WSB(WS_KN))
#define V_OF(hf)  ((hf) ? (bf16_t*)((unsigned char*)a.out + 192 * MiB) : WSB(WS_V))
            if (IN(16)) REP { pg8::Gemm g{WSB(WS_CKV), WSB(WS_WUKV), T_ALL, 2048, 256, 256, 0, 0, 0}; pg8::StaticOrder S; S.init(T_ALL, 2048, G, bid);
                pg8::EpiKV E{KN_OF(0), V_OF(0), KN_OF(1), V_OF(1)}; pg8::gemm_phase(LDSL, g, S, E, wv); }
            SYNC(16);
            if (IN(17)) {
#pragma unroll 1
                for (int hf = 0; hf < 2; ++hf) {
                    const int xcd = bid & 7, slot = bid >> 3;
                    for (int it = 0; it * G < 1024; ++it) {
                        int combo, qb;
                        if (G == 256) { if (hf == 0) { combo = it * 4 + (xcd >> 1); qb = (xcd & 1) * 32 + slot; } else { combo = it * 16 + xcd * 2 + (slot >> 4); qb = slot & 15; } }
                        else { const int u = it * G + bid; if (u >= 1024) break; if (hf == 0) { combo = u >> 6; qb = u & 63; } else { combo = u >> 4; qb = u & 15; } }
                        const int bt = combo >> 3, hh = combo & 7; const int seq = hf ? S_S : S_P;
                        const size_t tloc = (size_t)bt * seq, tglob = (size_t)hf * T_HALF + tloc;
                        bf16_t* qp = WSB(WS_Q) + (tglob + (size_t)qb * 256) * 1536 + hh * 192;
                        att::attn_unit(qp, KN_OF(hf) + tloc * 1024 + hh * 128, WSB(WS_KR) + tglob * 64, V_OF(hf) + tloc * 1024 + hh * 128, qp, seq, (char*)lds, wv, (const float*)WSB(WS_ROPE), qb * 256);
                    }
                }
            }
            SYNC(17);
#undef KN_OF
#undef V_OF
            if (IN(20)) REP { pg8::Gemm g{WSB(WS_Q), WSB(WS_WO), T_ALL, 1024, 1024, 1536, 0, 0, 1}; pg8::StaticOrder S; S.init(T_ALL, 1024, G, bid);
                pg8::EpiStore E{WSB(WS_M2), 1024, nullptr, nullptr}; pg8::gemm_phase(LDSL, g, S, E, wv); }
            SYNC(20);
            if (IN(21)) row_mid(WSB(WS_M2), a.norm_g + (4 + 1) * 1024, nullptr, nullptr, (const bf16_t*)a.out, WSB(WS_H), (float*)WSB(WS_RSTD), nullptr, G, bid, wv);
            SYNC(21);
        }
        FFN_PHASES(base, layer, layer == 1)
    }
#ifdef DBG_OFF
    if (hi >= 27) { grid.sync(); const bf16_t* sp = WSB(DBG_OFF);
        for (size_t i = (size_t)bid * 512 + otid(wv); i < (size_t)T_ALL * 1024; i += (size_t)G * 512) a.out[i] = bf2f(sp[i]); }
#endif
#undef IN
#undef SYNC
}

extern "C" void kernel_launch(void* const* d_in, const int* in_sizes, int n_in, void* d_out, int out_size, void* d_ws, size_t ws_size, hipStream_t stream) {
    static int grid = 0;
    if (grid == 0) {
        if (n_in != 14 || out_size != T_ALL * DM || ws_size < WS_END) { fprintf(stderr, "kernel_launch: unexpected shapes (n_in %d out %d ws %zu)\n", n_in, out_size, ws_size); grid = -1; return; }
        int dev = 0, cus = 0, per_cu = 0;
        (void)hipGetDevice(&dev); (void)hipDeviceGetAttribute(&cus, hipDeviceAttributeMultiprocessorCount, dev);
        if (hipFuncSetAttribute((const void*)mega, hipFuncAttributeMaxDynamicSharedMemorySize, LDS_BYTES) != hipSuccess) { fprintf(stderr, "kernel_launch: hipFuncSetAttribute failed\n"); grid = -1; return; }
        (void)hipOccupancyMaxActiveBlocksPerMultiprocessor(&per_cu, (const void*)mega, 512, LDS_BYTES);
        (void)hipGetLastError();
        if (per_cu < 1) per_cu = 1;
        grid = cus * 1;
    }
    if (grid < 0) return;
    Args a{};
    a.xp = (const float*)d_in[0]; a.xs = (const float*)d_in[1]; a.norm_g = (const float*)d_in[2]; a.fnet_w = (const float*)d_in[3]; a.fnet_b = (const float*)d_in[4];
    a.w_down = (const float*)d_in[5]; a.q_norm = (const float*)d_in[6]; a.w_uq = (const float*)d_in[7]; a.kv_norm = (const float*)d_in[8]; a.w_ukv = (const float*)d_in[9];
    a.w_o = (const float*)d_in[10]; a.w_gate = (const float*)d_in[11]; a.w_up = (const float*)d_in[12]; a.w_fdown = (const float*)d_in[13];
    a.out = (float*)d_out; a.ws = (unsigned char*)d_ws; a.ph_lo = 0; a.ph_hi = NPHASE;
    if (hipMemsetAsync(d_ws, 0, 16384, stream) != hipSuccess) { fprintf(stderr, "kernel_launch: memset failed\n"); return; }
    void* args[] = {&a};
    hipError_t e = hipLaunchCooperativeKernel((const void*)mega, dim3(grid), dim3(512), args, LDS_BYTES, stream);
    if (e != hipSuccess) fprintf(stderr, "cooperative launch failed: %s (grid %d)\n", hipGetErrorString(e), grid);
}
```
